# Optimizing an MI355X kernel written in HIP

```python
import math
import jax, jax.numpy as jnp
from jax import lax
import numpy as np

D_MODEL = 1024
BATCH = 16
SEQ = 2048
DEPTH = 1
DEC_BATCH = 16
DEC_SEQ = 16
PAST_LEN = 1024

CHUNK = 64
HEAD_DIM = 64
N_HEADS_A = 8
BAND_PAST_CHUNKS = 8
BAND_PAST = BAND_PAST_CHUNKS * CHUNK
BAND_LEN = (BAND_PAST_CHUNKS + 1) * CHUNK
REL_FUT = CHUNK - 1
REL_PAST = 256
N_REL = REL_FUT + REL_PAST + 1
N_HEADS_B = 4
WIDTH_A = N_HEADS_A * HEAD_DIM
WIDTH_B_QK = N_HEADS_B * 2 * HEAD_DIM
WIDTH_B_V = N_HEADS_B * 2 * HEAD_DIM
IN_WIDTH = 3 * WIDTH_A + 2 * WIDTH_B_QK + WIDTH_B_V
SPLITS = (WIDTH_A, 2 * WIDTH_A, 3 * WIDTH_A, 3 * WIDTH_A + WIDTH_B_QK, 3 * WIDTH_A + 2 * WIDTH_B_QK)
D_FF = 4 * D_MODEL
ROPE_THETA = 10000.0
Q_BLOCK = 128
EPS = 1e-6
NEG_INF = -1e30
ATTN_SCALE = HEAD_DIM ** -0.5

kernel_name = "hybrid_chunkband_diffattn_stream_step"


def rms_norm(x, g):
    xf = x.astype(jnp.float32)
    y = xf * lax.rsqrt(jnp.mean(xf * xf, axis=-1, keepdims=True) + EPS)
    return (y * g.astype(jnp.float32)).astype(x.dtype)


def rope(x, pos):
    half = HEAD_DIM // 2
    inv_freq = ROPE_THETA ** (-jnp.arange(half, dtype=jnp.float32) / half)
    ang = pos.astype(jnp.float32)[:, None] * inv_freq[None, :]
    cos = jnp.cos(ang)[:, None, None, :]
    sin = jnp.sin(ang)[:, None, None, :]
    xf = x.astype(jnp.float32)
    x1, x2 = xf[..., :half], xf[..., half:]
    return jnp.concatenate([x1 * cos - x2 * sin, x2 * cos + x1 * sin], axis=-1).astype(x.dtype)


def project_qkv(h, pos, w_in, qn_a, kn_a, qn_b, kn_b):
    b, s, _ = h.shape
    z = h @ w_in
    qa, ka, va, qb, kb, vb = jnp.split(z, SPLITS, axis=-1)
    qa = rms_norm(qa.reshape(b, s, N_HEADS_A, HEAD_DIM), qn_a)
    ka = rms_norm(ka.reshape(b, s, N_HEADS_A, HEAD_DIM), kn_a)
    va = va.reshape(b, s, N_HEADS_A, HEAD_DIM)
    qb = rope(rms_norm(qb.reshape(b, s, N_HEADS_B, 2, HEAD_DIM), qn_b), pos)
    kb = rope(rms_norm(kb.reshape(b, s, N_HEADS_B, 2, HEAD_DIM), kn_b), pos)
    vb = vb.reshape(b, s, N_HEADS_B, 2 * HEAD_DIM)
    return qa, ka, va, qb, kb, vb


def rel_bias_lookup(table, dist):
    idx = jnp.clip(dist, -REL_FUT, REL_PAST) + REL_FUT
    return table[:, idx].astype(jnp.float32)


def chunk_band_attn_prompt(q, k, v, rel_table):
    b, s, h, d = q.shape
    nc = s // CHUNK
    qc = q.reshape(b, nc, CHUNK, h, d)
    pad = ((0, 0), (BAND_PAST_CHUNKS, 0), (0, 0), (0, 0), (0, 0))
    kp = jnp.pad(k.reshape(b, nc, CHUNK, h, d), pad)
    vp = jnp.pad(v.reshape(b, nc, CHUNK, h, d), pad)
    band_idx = jnp.arange(nc)[:, None] + jnp.arange(BAND_PAST_CHUNKS + 1)[None, :]
    kband = kp[:, band_idx].reshape(b, nc, BAND_LEN, h, d)
    vband = vp[:, band_idx].reshape(b, nc, BAND_LEN, h, d)
    sc = jnp.einsum('bcqhd,bckhd->bhcqk', qc, kband).astype(jnp.float32) * ATTN_SCALE
    qi = jnp.arange(CHUNK)
    kj = jnp.arange(BAND_LEN)
    bias = rel_bias_lookup(rel_table, qi[:, None] + BAND_PAST - kj[None, :])
    k_valid = (jnp.arange(nc)[:, None] * CHUNK - BAND_PAST + kj[None, :]) >= 0
    sc = jnp.where(k_valid[None, None, :, None, :], sc + bias[None, :, None], NEG_INF)
    p = jax.nn.softmax(sc, axis=-1).astype(v.dtype)
    o = jnp.einsum('bhcqk,bckhd->bcqhd', p, vband)
    return o.reshape(b, s, h * d)


def chunk_band_attn_sample(q, k_new, v_new, k_cache, v_cache, rel_table):
    b, t, h, d = q.shape
    lc = k_cache.shape[1]
    keys = jnp.concatenate([k_cache, k_new], axis=1)
    vals = jnp.concatenate([v_cache, v_new], axis=1)
    q_pos = PAST_LEN + jnp.arange(t)
    k_pos = jnp.concatenate([PAST_LEN - lc + jnp.arange(lc), PAST_LEN + jnp.arange(t)])
    bias = rel_bias_lookup(rel_table, q_pos[:, None] - k_pos[None, :])
    sc = jnp.einsum('bqhd,bkhd->bhqk', q, keys).astype(jnp.float32) * ATTN_SCALE + bias[None]
    p = jax.nn.softmax(sc, axis=-1).astype(v_new.dtype)
    o = jnp.einsum('bhqk,bkhd->bqhd', p, vals)
    return o.reshape(b, t, h * d)


def diff_lambda(lq1, lk1, lq2, lk2, layer_idx):
    lam_init = 0.8 - 0.6 * math.exp(-0.3 * layer_idx)
    f = jnp.float32
    lam = (jnp.exp(jnp.sum(lq1.astype(f) * lk1.astype(f)))
           - jnp.exp(jnp.sum(lq2.astype(f) * lk2.astype(f))) + lam_init)
    return lam, lam_init


def diff_combine(sc, v, lam):
    p = jax.nn.softmax(sc, axis=-1)
    a = (p[:, :, 0] - lam * p[:, :, 1]).astype(v.dtype)
    return jnp.einsum('bhqk,bkhe->bqhe', a, v)


def diff_attn_prompt(q, k, v, lam):
    b, s, h, _, d = q.shape
    nb = s // Q_BLOCK
    q_blocks = jnp.moveaxis(q.reshape(b, nb, Q_BLOCK, h, 2, d), 1, 0)
    k_chunk = jnp.arange(s) // CHUNK

    def one_block(args):
        q_blk, start = args
        sc = jnp.einsum('bqhrd,bkhrd->bhrqk', q_blk, k).astype(jnp.float32) * ATTN_SCALE
        q_chunk = (start + jnp.arange(Q_BLOCK)) // CHUNK
        visible = k_chunk[None, :] <= q_chunk[:, None]
        sc = jnp.where(visible, sc, NEG_INF)
        return diff_combine(sc, v, lam)

    o = lax.map(one_block, (q_blocks, jnp.arange(nb) * Q_BLOCK))
    return jnp.moveaxis(o, 0, 1).reshape(b, s, h, 2 * d)


def diff_attn_sample(q, k_new, v_new, k_cache, v_cache, lam):
    keys = jnp.concatenate([k_cache, k_new], axis=1)
    vals = jnp.concatenate([v_cache, v_new], axis=1)
    sc = jnp.einsum('bqhrd,bkhrd->bhrqk', q, keys).astype(jnp.float32) * ATTN_SCALE
    return diff_combine(sc, vals, lam)


def diff_finish(o, subln_g, lam_init):
    b, s = o.shape[:2]
    return (rms_norm(o, subln_g) * (1.0 - lam_init)).reshape(b, s, WIDTH_B_V)


def gated_merge(h, ya, yb, w_gate, b_gate, w_proj_a, w_proj_b, w_out):
    g = jax.nn.sigmoid(h @ w_gate + b_gate)
    g_a, g_b = g[..., :D_MODEL], g[..., D_MODEL:]
    return (g_a * (ya @ w_proj_a) + g_b * (yb @ w_proj_b)) @ w_out


def sq_relu_mlp(x, g, w1, w2):
    u = jax.nn.relu(rms_norm(x, g) @ w1)
    return (u * u) @ w2


def setup_inputs(seed: int = 0) -> dict:
    key = jax.random.key(seed)
    ks = jax.random.split(key, 32)
    f32 = jnp.float32

    def nrm(k, shape, scale=1.0):
        return jax.random.normal(k, shape, f32) * scale

    def gain(k, shape):
        return 1.0 + 0.01 * jax.random.normal(k, shape, f32)

    la = min(BAND_PAST, PAST_LEN)
    return {
        "x_prompt": nrm(ks[0], (BATCH, SEQ, D_MODEL)),
        "x_sample": nrm(ks[1], (DEC_BATCH, DEC_SEQ, D_MODEL)),
        "cache_a_k": nrm(ks[2], (DEPTH, DEC_BATCH, la, N_HEADS_A, HEAD_DIM)),
        "cache_a_v": nrm(ks[3], (DEPTH, DEC_BATCH, la, N_HEADS_A, HEAD_DIM)),
        "cache_b_k": nrm(ks[4], (DEPTH, DEC_BATCH, PAST_LEN, N_HEADS_B, 2, HEAD_DIM)),
        "cache_b_v": nrm(ks[5], (DEPTH, DEC_BATCH, PAST_LEN, N_HEADS_B, 2 * HEAD_DIM)),
        "ln1_g": gain(ks[6], (DEPTH, D_MODEL)),
        "w_in": nrm(ks[7], (DEPTH, D_MODEL, IN_WIDTH), D_MODEL ** -0.5),
        "qn_a": gain(ks[8], (DEPTH, HEAD_DIM)),
        "kn_a": gain(ks[9], (DEPTH, HEAD_DIM)),
        "rel_bias": nrm(ks[10], (DEPTH, N_HEADS_A, N_REL), 0.1),
        "qn_b": gain(ks[11], (DEPTH, HEAD_DIM)),
        "kn_b": gain(ks[12], (DEPTH, HEAD_DIM)),
        "lam_q1": nrm(ks[13], (DEPTH, HEAD_DIM), 0.1),
        "lam_k1": nrm(ks[14], (DEPTH, HEAD_DIM), 0.1),
        "lam_q2": nrm(ks[15], (DEPTH, HEAD_DIM), 0.1),
        "lam_k2": nrm(ks[16], (DEPTH, HEAD_DIM), 0.1),
        "subln_g": gain(ks[17], (DEPTH, 2 * HEAD_DIM)),
        "w_gate": nrm(ks[18], (DEPTH, D_MODEL, 2 * D_MODEL), D_MODEL ** -0.5),
        "b_gate": nrm(ks[19], (DEPTH, 2 * D_MODEL), 0.01),
        "w_proj_a": nrm(ks[20], (DEPTH, WIDTH_A, D_MODEL), WIDTH_A ** -0.5),
        "w_proj_b": nrm(ks[21], (DEPTH, WIDTH_B_V, D_MODEL), WIDTH_B_V ** -0.5),
        "w_out": nrm(ks[22], (DEPTH, D_MODEL, D_MODEL), D_MODEL ** -0.5),
        "ln2_g": gain(ks[23], (DEPTH, D_MODEL)),
        "w_ff1": nrm(ks[24], (DEPTH, D_MODEL, D_FF), D_MODEL ** -0.5),
        "w_ff2": nrm(ks[25], (DEPTH, D_FF, D_MODEL), D_FF ** -0.5),
    }


def reference(x_prompt, x_sample, cache_a_k, cache_a_v, cache_b_k, cache_b_v,
              ln1_g, w_in, qn_a, kn_a, rel_bias, qn_b, kn_b,
              lam_q1, lam_k1, lam_q2, lam_k2, subln_g,
              w_gate, b_gate, w_proj_a, w_proj_b, w_out,
              ln2_g, w_ff1, w_ff2):
    s_p = x_prompt.shape[1]
    t_s = x_sample.shape[1]
    pos_p = jnp.arange(s_p)
    pos_s = PAST_LEN + jnp.arange(t_s)
    keep_p = min(BAND_PAST, s_p)
    xp, xs = x_prompt, x_sample
    ak_p, av_p, bk_p, bv_p = [], [], [], []
    ak_s, av_s, bk_s, bv_s = [], [], [], []
    for l in range(DEPTH):
        lam, lam_init = diff_lambda(lam_q1[l], lam_k1[l], lam_q2[l], lam_k2[l], l)

        hp = rms_norm(xp, ln1_g[l])
        qa, ka, va, qb, kb, vb = project_qkv(hp, pos_p, w_in[l], qn_a[l], kn_a[l], qn_b[l], kn_b[l])
        ya = chunk_band_attn_prompt(qa, ka, va, rel_bias[l])
        yb = diff_finish(diff_attn_prompt(qb, kb, vb, lam), subln_g[l], lam_init)
        xp = xp + gated_merge(hp, ya, yb, w_gate[l], b_gate[l], w_proj_a[l], w_proj_b[l], w_out[l])
        xp = xp + sq_relu_mlp(xp, ln2_g[l], w_ff1[l], w_ff2[l])
        ak_p.append(ka[:, s_p - keep_p:])
        av_p.append(va[:, s_p - keep_p:])
        bk_p.append(kb)
        bv_p.append(vb)

        hs = rms_norm(xs, ln1_g[l])
        qa, ka, va, qb, kb, vb = project_qkv(hs, pos_s, w_in[l], qn_a[l], kn_a[l], qn_b[l], kn_b[l])
        ya = chunk_band_attn_sample(qa, ka, va, cache_a_k[l], cache_a_v[l], rel_bias[l])
        yb = diff_finish(diff_attn_sample(qb, kb, vb, cache_b_k[l], cache_b_v[l], lam), subln_g[l], lam_init)
        xs = xs + gated_merge(hs, ya, yb, w_gate[l], b_gate[l], w_proj_a[l], w_proj_b[l], w_out[l])
        xs = xs + sq_relu_mlp(xs, ln2_g[l], w_ff1[l], w_ff2[l])
        ak_s.append(ka)
        av_s.append(va)
        bk_s.append(kb)
        bv_s.append(vb)

    return (xp, xs,
            jnp.stack(ak_p), jnp.stack(av_p), jnp.stack(bk_p), jnp.stack(bv_p),
            jnp.stack(ak_s), jnp.stack(av_s), jnp.stack(bk_s), jnp.stack(bv_s))
```

```cpp
#include <hip/hip_runtime.h>
#include <hip/hip_cooperative_groups.h>
#include <cstdio>
#include <cstdint>
namespace cg = cooperative_groups;

constexpr int MROWS = 33024;
constexpr size_t MiB = 1u << 20;
constexpr size_t WS_WIN = 1 * MiB, WS_WPA = 11 * MiB, WS_WPB = 12 * MiB, WS_WOUT = 13 * MiB, WS_WFF1 = 15 * MiB, WS_WFF2 = 23 * MiB;
constexpr size_t WS_COS = 31 * MiB, WS_SIN = 31 * MiB + 256 * 1024, WS_SSQ = 31 * MiB + 512 * 1024;
constexpr size_t WS_H = 32 * MiB;
constexpr size_t WS_YA = 404 * MiB + 512 * 1024, WS_YB = 436 * MiB + 768 * 1024;
constexpr size_t WS_RINV = 31 * MiB + 768 * 1024;
constexpr size_t WS_QKV = 97 * MiB;
constexpr size_t WS_QAS = 289 * MiB, WS_QBS = 289 * MiB + 256 * 1024, WS_KAS = 289 * MiB + 512 * 1024, WS_VAST = 298 * MiB, WS_KBS = 306 * MiB + 512 * 1024, WS_VBST = 323 * MiB;
constexpr size_t WS_GATE = 340 * MiB;
constexpr size_t WS_X1G = 340 * MiB;
constexpr size_t WS_MBUF = 97 * MiB;
constexpr size_t WS_U = 32 * MiB;
constexpr size_t WS_BAR = 0;
constexpr size_t WS_PART = 469 * MiB;
constexpr size_t WS_END = 485 * MiB;
constexpr int SPA = 544, SOA = 512, SPB = 1056, SOB = 1024;
constexpr size_t O_Y = 0, O_AKP = 33816576, O_AVP = 38010880, O_BKP = 42205184, O_BVP = 58982400, O_AKS = 75759616, O_AVS = 75890688, O_BKS = 76021760, O_BVS = 76152832;
__device__ __forceinline__ int lane_id() { int l; asm volatile("v_mbcnt_lo_u32_b32 %0, -1, 0\n\tv_mbcnt_hi_u32_b32 %0, -1, %0" : "=v"(l)); return l; }
constexpr float EPSN = 1e-6f, LOG2E = 1.4426950408889634f, QSCALE = 0.125f * 1.4426950408889634f;

namespace pg8 {
#define PG8_LAS __attribute__((address_space(3)))
typedef unsigned short bf16_t;
typedef short bf16x8 __attribute__((ext_vector_type(8)));
typedef float f32x4 __attribute__((ext_vector_type(4)));
typedef unsigned u32x4 __attribute__((ext_vector_type(4)));
constexpr int BM = 256, BK = 64, HALF = 128, HTB = HALF * BK * 2  , STAGE_BYTES = 8 * HTB, NXCD = 8, WGM = 8;

__host__ __device__ __forceinline__ int lds_byte(int r, int c) { const int st = (r >> 4) * 2 + (c >> 5), rr = r & 15, cc = c & 31, ob = rr * 64 + cc * 2; return st * 1024 + (ob ^ (((ob >> 9) & 1) << 5)); }
__host__ __device__ __forceinline__ void stage_rc(int b, int& R, int& C) { const int st = b / 1024, sb = b % 1024, swz = sb ^ (((sb >> 9) & 1) << 5); R = (st >> 1) * 16 + swz / 64; C = (st & 1) * 32 + (swz % 64) / 2; }
__host__ __device__ __forceinline__ int perm32(int rho) { const int n = rho >> 4, i = rho & 15; return 8 * (i >> 2) + 4 * n + (i & 3); }

struct Unit { int pm, pn; };
struct Gemm { const bf16_t* A; const bf16_t* Bt; int M, N, K, KL; };

struct StaticOrder {
    int nM, nN, nwg, G, c;
    __host__ __device__ void init(int M, int N, int G_, int c_) { nM = M / BM; nN = N / BM; nwg = nM * nN; G = G_; c = c_; }
    __host__ __device__ bool next(int i, Unit& u) const {
        const long L = (long)i * G + c; if (L >= nwg) return false;
        int wgid = (int)L; { const int q = nwg / NXCD, r = nwg % NXCD, xcd = wgid % NXCD, off = wgid / NXCD; wgid = (xcd < r ? xcd * (q + 1) : r * (q + 1) + (xcd - r) * q) + off; }
        const int nig = WGM * nN, gid = wgid / nig, fm = gid * WGM, gsz = (nM - fm) < WGM ? (nM - fm) : WGM;
        u.pm = fm + ((wgid % nig) % gsz); u.pn = (wgid % nig) / gsz; return true;
    }
    __device__ __forceinline__ void a_ready(const Unit&) const {}
    __device__ __forceinline__ void done(const Unit&) const {}
};

__device__ __forceinline__ unsigned cvt_pk_bf16(float lo, float hi) { unsigned r; asm volatile("v_cvt_pk_bf16_f32 %0, %1, %2" : "=v"(r) : "v"(lo), "v"(hi)); return r; }
typedef float f32x2 __attribute__((ext_vector_type(2)));
typedef float f32x2e __attribute__((ext_vector_type(2))); typedef __bf16 bf16x2e __attribute__((ext_vector_type(2)));
__device__ __forceinline__ unsigned pkbf(float lo, float hi) { f32x2e v = {lo, hi}; bf16x2e b = __builtin_convertvector(v, bf16x2e); return __builtin_bit_cast(unsigned, b); }
__device__ __forceinline__ u32x4 pk8(const f32x4& a, const f32x4& b) { u32x4 w; w.x = pkbf(a[0], a[1]); w.y = pkbf(a[2], a[3]); w.z = pkbf(b[0], b[1]); w.w = pkbf(b[2], b[3]); return w; }
__device__ __forceinline__ float bflo(unsigned w) { return __uint_as_float(w << 16); }
__device__ __forceinline__ float bfhi(unsigned w) { return __uint_as_float(w & 0xffff0000u); }
typedef unsigned u32x2q __attribute__((ext_vector_type(2)));
__device__ __forceinline__ unsigned q8(const f32x4& g) {
    return (unsigned)(g[0] * 255.0f + 0.5f) | ((unsigned)(g[1] * 255.0f + 0.5f) << 8) | ((unsigned)(g[2] * 255.0f + 0.5f) << 16) | ((unsigned)(g[3] * 255.0f + 0.5f) << 24); }
__device__ __forceinline__ f32x4 dq8(unsigned w) { return (f32x4){(float)(w & 0xffu), (float)((w >> 8) & 0xffu), (float)((w >> 16) & 0xffu), (float)(w >> 24)} * (1.0f / 255.0f); }
__device__ __forceinline__ float sigm(float x) { return __builtin_amdgcn_rcpf(1.0f + __builtin_amdgcn_exp2f(-x * LOG2E)); }

struct EpiP1 {
    static constexpr bool PERM = true, AFTER_DRAIN = false;
    unsigned char* ws; float* out; const float *qn_a, *kn_a, *qn_b, *kn_b, *b_gate;
    __device__ __forceinline__ void operator()(const f32x4 (&acc)[2][2][4][2], const Unit& u, int wr, int wc, int fr, int fq) const {
        const int seg = u.pn >> 1;
        if (seg >= 6) {
            unsigned char* G = ws + WS_GATE;
            const int gc0 = u.pn * 256 - 3072 + wc * 64 + 8 * fq;
            f32x4 bv[2][2];
#pragma unroll
            for (int bj = 0; bj < 2; ++bj)
#pragma unroll
                for (int n = 0; n < 2; ++n) bv[bj][n] = *(const f32x4*)(b_gate + gc0 + 32 * bj + 4 * n);
#pragma unroll
            for (int ai = 0; ai < 2; ++ai)
#pragma unroll
                for (int m = 0; m < 4; ++m) {
                    int lrow = ai * 128 + wr * 64 + m * 16 + fr; asm volatile("" : "+v"(lrow));
                    const size_t row = (size_t)u.pm * 256 + lrow; unsigned char* rp = G + row * 2048 + gc0;
#pragma unroll
                    for (int bj = 0; bj < 2; ++bj) { f32x4 v0 = acc[ai][bj][m][0] + bv[bj][0], v1 = acc[ai][bj][m][1] + bv[bj][1];
#pragma unroll
                        for (int e = 0; e < 4; ++e) { v0[e] = sigm(v0[e]); v1[e] = sigm(v1[e]); }
                        u32x2q w; w.x = q8(v0); w.y = q8(v1); *(u32x2q*)(rp + 32 * bj) = w; }
                    asm volatile("" ::: "memory");
                }
            return;
        }
        const int h64 = (u.pn & 1) * 4 + wc;
        const bool samp = (u.pm == 128);
        const int kind = seg % 3;
        const bool isB = seg >= 3;
        const float* gain = kind == 2 ? nullptr : (isB ? (kind == 0 ? qn_b : kn_b) : (kind == 0 ? qn_a : kn_a));
        const bool rope = isB && kind != 2;
        bf16_t* base_p = (bf16_t*)(ws + WS_QKV + (size_t)seg * 32 * MiB);
        bf16_t* base_s = (bf16_t*)(ws + (seg == 0 ? WS_QAS : seg == 1 ? WS_KAS : seg == 2 ? WS_VAST : seg == 3 ? WS_QBS : seg == 4 ? WS_KBS : WS_VBST));
        const int spitch = kind == 0 ? 16 : (isB ? SPB : SPA), soff = kind == 0 ? 0 : (isB ? SOB : SOA);
        float* outp = out + (seg == 1 ? O_AKP : seg == 2 ? O_AVP : seg == 4 ? O_BKP : O_BVP);
        float* outs = out + (seg == 1 ? O_AKS : seg == 2 ? O_AVS : seg == 4 ? O_BKS : O_BVS);
        const int keep0 = isB ? 0 : 1536, orows = isB ? 2048 : 512;
        const float* cosT = (const float*)(ws + WS_COS); const float* sinT = (const float*)(ws + WS_SIN);
        f32x4 gq[2][2];
#pragma unroll
        for (int bj = 0; bj < 2; ++bj)
#pragma unroll
            for (int n = 0; n < 2; ++n) gq[bj][n] = gain ? *(const f32x4*)(gain + 32 * bj + 8 * fq + 4 * n) : (f32x4){1.f, 1.f, 1.f, 1.f};
#pragma unroll
        for (int ai = 0; ai < 2; ++ai)
#pragma unroll
            for (int m = 0; m < 4; ++m) {
                int lrow = ai * 128 + wr * 64 + m * 16 + fr; asm volatile("" : "+v"(lrow));
                int b, s, pos; if (!samp) { b = u.pm >> 3; s = (u.pm & 7) * 256 + lrow; pos = s; } else { b = lrow >> 4; s = lrow & 15; pos = 1024 + s; }
                f32x4 v[2][2];
#pragma unroll
                for (int bj = 0; bj < 2; ++bj)
#pragma unroll
                    for (int n = 0; n < 2; ++n) v[bj][n] = acc[ai][bj][m][n];
                if (gain) {
                    float ss = 0.f;
#pragma unroll
                    for (int bj = 0; bj < 2; ++bj)
#pragma unroll
                        for (int n = 0; n < 2; ++n) ss += (v[bj][n][0] * v[bj][n][0] + v[bj][n][1] * v[bj][n][1]) + (v[bj][n][2] * v[bj][n][2] + v[bj][n][3] * v[bj][n][3]);
                    ss += __shfl_xor(ss, 16); ss += __shfl_xor(ss, 32);
                    const float rstd = 1.0f / sqrtf(ss * (1.0f / 64.0f) + EPSN);
#pragma unroll
                    for (int bj = 0; bj < 2; ++bj)
#pragma unroll
                        for (int n = 0; n < 2; ++n) v[bj][n] = v[bj][n] * rstd * gq[bj][n];
                }
                if (rope) {
#pragma unroll
                    for (int n = 0; n < 2; ++n) { const f32x4 c = *(const f32x4*)(cosT + pos * 32 + 8 * fq + 4 * n), sn = *(const f32x4*)(sinT + pos * 32 + 8 * fq + 4 * n);
                        const f32x4 x1 = v[0][n], x2 = v[1][n]; v[0][n] = x1 * c - x2 * sn; v[1][n] = x2 * c + x1 * sn; }
                }
                if (kind != 0) {
                    float* op = nullptr;
                    if (!samp) { if (s >= keep0) op = outp + (((size_t)b * orows + (s - keep0)) * 8 + h64) * 64; } else op = outs + ((size_t)(b * 16 + s) * 8 + h64) * 64;
                    if (op) {
#pragma unroll
                        for (int bj = 0; bj < 2; ++bj)
#pragma unroll
                            for (int n = 0; n < 2; ++n) *(f32x4*)(op + 32 * bj + 8 * fq + 4 * n) = v[bj][n];
                    }
                }
                if (kind == 2) {
                    bf16_t* dp; size_t pitch;
                    if (!samp) { dp = base_p + ((size_t)(b * 8 + h64) * 64) * 2048 + s; pitch = 2048; } else { dp = base_s + ((size_t)(b * 8 + h64) * 64) * spitch + soff + s; pitch = spitch; }
#pragma unroll
                    for (int bj = 0; bj < 2; ++bj)
#pragma unroll
                        for (int n = 0; n < 2; ++n)
#pragma unroll
                            for (int e = 0; e < 4; ++e) dp[(size_t)(32 * bj + 8 * fq + 4 * n + e) * pitch] = (bf16_t)(pkbf(v[bj][n][e], 0.f) & 0xffffu);
                } else {
                    const float sc = kind == 0 ? QSCALE : 1.0f;
                    bf16_t* dp = !samp ? base_p + ((size_t)(b * 8 + h64) * 2048 + s) * 64 : base_s + ((size_t)(b * 8 + h64) * spitch + soff + s) * 64;
#pragma unroll
                    for (int bj = 0; bj < 2; ++bj) *(u32x4*)(dp + 32 * bj + 8 * fq) = pk8(v[bj][0] * sc, v[bj][1] * sc);
                }
                asm volatile("" ::: "memory");
            }
    }
};

template <int PASS> struct EpiP3 {
    static constexpr bool PERM = true, AFTER_DRAIN = false;
    const unsigned char* G; bf16_t* mb;
    __device__ __forceinline__ void operator()(const f32x4 (&acc)[2][2][4][2], const Unit& u, int wr, int wc, int fr, int fq) const {
#pragma unroll
        for (int ai = 0; ai < 2; ++ai) {
            u32x2q gw[4][2]; u32x4 pw[4][2];
#pragma unroll
            for (int m = 0; m < 4; ++m) { const size_t row = (size_t)u.pm * 256 + ai * 128 + wr * 64 + m * 16 + fr;
#pragma unroll
                for (int bj = 0; bj < 2; ++bj) { const int c0 = u.pn * 256 + wc * 64 + 32 * bj + 8 * fq;
                    gw[m][bj] = *(const u32x2q*)(G + row * 2048 + (PASS ? 1024 : 0) + c0);
                    if (PASS == 1) pw[m][bj] = *(const u32x4*)(mb + row * 1024 + c0); } }
            asm volatile("" ::: "memory");
#pragma unroll
            for (int m = 0; m < 4; ++m) { const size_t row = (size_t)u.pm * 256 + ai * 128 + wr * 64 + m * 16 + fr;
#pragma unroll
                for (int bj = 0; bj < 2; ++bj) { const int c0 = u.pn * 256 + wc * 64 + 32 * bj + 8 * fq; const u32x2q g = gw[m][bj];
                    const f32x4 g0 = dq8(g.x), g1 = dq8(g.y);
                    f32x4 v0 = acc[ai][bj][m][0] * g0, v1 = acc[ai][bj][m][1] * g1;
                    if (PASS == 1) { const u32x4 q = pw[m][bj];
                        v0 += (f32x4){bflo(q.x), bfhi(q.x), bflo(q.y), bfhi(q.y)}; v1 += (f32x4){bflo(q.z), bfhi(q.z), bflo(q.w), bfhi(q.w)}; }
                    *(u32x4*)(mb + row * 1024 + c0) = pk8(v0, v1); } }
            asm volatile("" ::: "memory");
        }
    }
};
struct EpiP4 {
    static constexpr bool PERM = true, AFTER_DRAIN = false;
    const bf16_t* H; const float* rinv; const float* g1; bf16_t* x1b; float* ssq;
    __device__ __forceinline__ void operator()(const f32x4 (&acc)[2][2][4][2], const Unit& u, int wr, int wc, int fr, int fq) const {
        f32x4 gi[2][2];
#pragma unroll
        for (int bj = 0; bj < 2; ++bj)
#pragma unroll
            for (int n = 0; n < 2; ++n) { const f32x4 g = *(const f32x4*)(g1 + u.pn * 256 + wc * 64 + 32 * bj + 8 * fq + 4 * n); gi[bj][n] = (f32x4){1.0f / g[0], 1.0f / g[1], 1.0f / g[2], 1.0f / g[3]}; }
#pragma unroll
        for (int ai = 0; ai < 2; ++ai) {
            u32x4 hv[4][2]; float rv[4];
#pragma unroll
            for (int m = 0; m < 4; ++m) { const size_t row = (size_t)u.pm * 256 + ai * 128 + wr * 64 + m * 16 + fr; rv[m] = rinv[row];
#pragma unroll
                for (int bj = 0; bj < 2; ++bj) hv[m][bj] = *(const u32x4*)(H + row * 1024 + u.pn * 256 + wc * 64 + 32 * bj + 8 * fq); }
            asm volatile("" ::: "memory");
#pragma unroll
            for (int m = 0; m < 4; ++m) { const size_t row = (size_t)u.pm * 256 + ai * 128 + wr * 64 + m * 16 + fr;
                float ss = 0.f;
#pragma unroll
                for (int bj = 0; bj < 2; ++bj) { const int c0 = u.pn * 256 + wc * 64 + 32 * bj + 8 * fq; const u32x4 q = hv[m][bj];
                    const f32x4 v0 = (f32x4){bflo(q.x), bfhi(q.x), bflo(q.y), bfhi(q.y)} * rv[m] * gi[bj][0] + acc[ai][bj][m][0], v1 = (f32x4){bflo(q.z), bfhi(q.z), bflo(q.w), bfhi(q.w)} * rv[m] * gi[bj][1] + acc[ai][bj][m][1];
                    ss += (v0[0] * v0[0] + v0[1] * v0[1]) + (v0[2] * v0[2] + v0[3] * v0[3]) + (v1[0] * v1[0] + v1[1] * v1[1]) + (v1[2] * v1[2] + v1[3] * v1[3]);
                    *(u32x4*)(x1b + row * 1024 + c0) = pk8(v0, v1); }
                ss += __shfl_xor(ss, 16); ss += __shfl_xor(ss, 32);
                if (fq == 0) atomicAdd(ssq + row, ss); }
            asm volatile("" ::: "memory");
        }
    }
};
struct EpiP5 {
    static constexpr bool PERM = true, AFTER_DRAIN = false;
    const float* ssq; bf16_t* U;
    __device__ __forceinline__ void operator()(const f32x4 (&acc)[2][2][4][2], const Unit& u, int wr, int wc, int fr, int fq) const {
#pragma unroll
        for (int ai = 0; ai < 2; ++ai)
#pragma unroll
            for (int m = 0; m < 4; ++m) {
                const size_t row = (size_t)u.pm * 256 + ai * 128 + wr * 64 + m * 16 + fr;
                const float rstd = 1.0f / sqrtf(ssq[row] * (1.0f / 1024.0f) + EPSN);
#pragma unroll
                for (int bj = 0; bj < 2; ++bj) { const int c0 = u.pn * 256 + wc * 64 + 32 * bj + 8 * fq;
                    f32x4 v0 = acc[ai][bj][m][0] * rstd, v1 = acc[ai][bj][m][1] * rstd;
#pragma unroll
                    for (int e = 0; e < 4; ++e) { const float a = fmaxf(v0[e], 0.f), b = fmaxf(v1[e], 0.f); v0[e] = a * a; v1[e] = b * b; }
                    *(u32x4*)(U + row * 4096 + c0) = pk8(v0, v1); }
            }
    }
};
struct EpiP6 {
    static constexpr bool PERM = true, AFTER_DRAIN = false;
    const bf16_t* x1b; float* y;
    __device__ __forceinline__ void operator()(const f32x4 (&acc)[2][2][4][2], const Unit& u, int wr, int wc, int fr, int fq) const {
#pragma unroll
        for (int ai = 0; ai < 2; ++ai) {
            u32x4 xv[4][2];
#pragma unroll
            for (int m = 0; m < 4; ++m) { const size_t row = (size_t)u.pm * 256 + ai * 128 + wr * 64 + m * 16 + fr;
#pragma unroll
                for (int bj = 0; bj < 2; ++bj) xv[m][bj] = *(const u32x4*)(x1b + row * 1024 + u.pn * 256 + wc * 64 + 32 * bj + 8 * fq); }
            asm volatile("" ::: "memory");
#pragma unroll
            for (int m = 0; m < 4; ++m) { const size_t row = (size_t)u.pm * 256 + ai * 128 + wr * 64 + m * 16 + fr;
#pragma unroll
                for (int bj = 0; bj < 2; ++bj) { float* pp = y + row * 1024 + u.pn * 256 + wc * 64 + 32 * bj + 8 * fq; const u32x4 q = xv[m][bj];
                    *(f32x4*)pp = (f32x4){bflo(q.x), bfhi(q.x), bflo(q.y), bfhi(q.y)} + acc[ai][bj][m][0]; *(f32x4*)(pp + 4) = (f32x4){bflo(q.z), bfhi(q.z), bflo(q.w), bfhi(q.w)} + acc[ai][bj][m][1]; } }
            asm volatile("" ::: "memory");
        }
    }
};
struct EpiP3Part {
    static constexpr bool PERM = true, AFTER_DRAIN = false;
    const unsigned char* G; int goff; float* part;
    __device__ __forceinline__ void operator()(const f32x4 (&acc)[2][2][4][2], const Unit& u, int wr, int wc, int fr, int fq) const {
#pragma unroll
        for (int ai = 0; ai < 2; ++ai)
#pragma unroll
            for (int m = 0; m < 4; ++m) {
                const size_t row = (size_t)ai * 128 + wr * 64 + m * 16 + fr;
#pragma unroll
                for (int bj = 0; bj < 2; ++bj) { const int c0 = u.pn * 256 + wc * 64 + 32 * bj + 8 * fq;
                    const u32x2q g = *(const u32x2q*)(G + ((size_t)32768 + row) * 2048 + goff + c0);
                    float* pp = part + row * 1024 + c0;
                    *(f32x4*)pp = acc[ai][bj][m][0] * dq8(g.x); *(f32x4*)(pp + 4) = acc[ai][bj][m][1] * dq8(g.y); }
            }
    }
};
struct OneUnit {
    int ok, pn;
    __device__ __forceinline__ bool next(int i, Unit& u) const { if (i != 0 || !ok) return false; u.pm = 0; u.pn = pn; return true; }
    __device__ __forceinline__ void a_ready(const Unit&) const {}
    __device__ __forceinline__ void done(const Unit&) const {}
};
struct EpiP6Part {
    static constexpr bool PERM = true, AFTER_DRAIN = false;
    float* part;
    __device__ __forceinline__ void operator()(const f32x4 (&acc)[2][2][4][2], const Unit& u, int wr, int wc, int fr, int fq) const {
#pragma unroll
        for (int ai = 0; ai < 2; ++ai)
#pragma unroll
            for (int m = 0; m < 4; ++m) {
                const size_t row = (size_t)ai * 128 + wr * 64 + m * 16 + fr;
#pragma unroll
                for (int bj = 0; bj < 2; ++bj) { float* pp = part + row * 1024 + u.pn * 256 + wc * 64 + 32 * bj + 8 * fq;
                    *(f32x4*)pp = acc[ai][bj][m][0]; *(f32x4*)(pp + 4) = acc[ai][bj][m][1]; }
            }
    }
};

template <class Epi, class Sched, bool ALIGN_EPI = false, bool SP2 = false>
__device__ __forceinline__ void gemm_phase(PG8_LAS unsigned char* lds, const Gemm g, const Sched& S, const Epi& E) {
    int tid_ = threadIdx.x; asm volatile("" : "+v"(tid_));
    const int tid = tid_, wid = __builtin_amdgcn_readfirstlane(tid >> 6), lane = tid & 63, wr = wid >> 2, wc = wid & 3, fr = lane & 15, fq = lane >> 4;
    const int K = g.K, nt = g.KL / BK;
    unsigned voffA[2], voffB[2];
#pragma unroll
    for (int i = 0; i < 2; ++i) { int R, C; stage_rc(tid * 16 + i * 8192, R, C); const int Rb = Epi::PERM ? ((R & ~31) + perm32(R & 31)) : R;
        voffA[i] = (unsigned)(R * K + C) * 2u; voffB[i] = (unsigned)(Rb * K + C) * 2u; }
    const size_t kstep = (size_t)(BK * 2);
    const size_t hstep = (size_t)HALF * K * 2;
    const size_t tstep = 2 * hstep;
    const unsigned ldsw = (unsigned)wid * 1024u;
    const int aoff = lds_byte(wr * 64 + fr, fq * 8), boff = lds_byte(wc * 32 + fr, fq * 8);
#define PG8_SA(b, h) (((b) * 2 + (h)) * HTB)
#define PG8_SB(b, h) ((4 + (b) * 2 + (h)) * HTB)
#define PG8_STAGE(bufoff, gbase, voff) do { _Pragma("unroll") for (int _i = 0; _i < 2; ++_i) \
        __builtin_amdgcn_global_load_lds((const unsigned*)((const char*)(gbase) + (voff)[_i]), (PG8_LAS unsigned*)(lds + (bufoff) + ldsw + _i * 8192), 16, 0, 0); } while (0)
#define PG8_LDA(dst, b, h) do { _Pragma("unroll") for (int m = 0; m < 4; ++m) _Pragma("unroll") for (int k = 0; k < 2; ++k) dst[m][k] = *(const PG8_LAS bf16x8*)(lds + PG8_SA(b, h) + aoff + m * 2048 + k * 1024); } while (0)
#define PG8_LDB(dst, b, h) do { _Pragma("unroll") for (int n = 0; n < 2; ++n) _Pragma("unroll") for (int k = 0; k < 2; ++k) dst[n][k] = *(const PG8_LAS bf16x8*)(lds + PG8_SB(b, h) + boff + n * 2048 + k * 1024); } while (0)
#define PG8_MMA(ai, bj, At, Bt) do { __builtin_amdgcn_s_setprio(1); _Pragma("unroll") for (int m = 0; m < 4; ++m) _Pragma("unroll") for (int n = 0; n < 2; ++n) _Pragma("unroll") for (int k = 0; k < 2; ++k) \
        acc[ai][bj][m][n] = __builtin_amdgcn_mfma_f32_16x16x32_bf16(Bt[n][k], At[m][k], acc[ai][bj][m][n], 0, 0, 0); __builtin_amdgcn_s_setprio(0); } while (0)
#define PG8_WAIT_V(n) asm volatile("s_waitcnt vmcnt(" #n ")" ::: "memory")
#define PG8_WAIT_L(n) asm volatile("s_waitcnt lgkmcnt(" #n ")" ::: "memory")
#define PG8_BAR __builtin_amdgcn_s_barrier()
#define PG8_SCHED __builtin_amdgcn_sched_barrier(0)
    Unit cur, nxt; int ui = 0;
    if (!S.next(0, cur)) return;
    f32x4 acc[2][2][4][2];
#pragma unroll
    for (int a = 0; a < 2; ++a)
#pragma unroll
        for (int b = 0; b < 2; ++b)
#pragma unroll
            for (int m = 0; m < 4; ++m)
#pragma unroll
                for (int n = 0; n < 2; ++n) acc[a][b][m][n] = (f32x4){0.f, 0.f, 0.f, 0.f};
    bf16x8 At[4][2], B0[2][2], B1[2][2];
    const char* cA = (const char*)g.A + (size_t)cur.pm * tstep; const char* cB = (const char*)g.Bt + (size_t)cur.pn * tstep;
    S.a_ready(cur);
    if constexpr (SP2) {
        PG8_STAGE(PG8_SB(0, 0), cB, voffB); PG8_STAGE(PG8_SB(0, 1), cB + hstep, voffB); PG8_STAGE(PG8_SA(0, 0), cA, voffA); PG8_STAGE(PG8_SA(0, 1), cA + hstep, voffA);
        if (wr == 1) PG8_BAR;
        PG8_WAIT_V(2); PG8_BAR;
        PG8_STAGE(PG8_SB(1, 0), cB + kstep, voffB); PG8_STAGE(PG8_SA(1, 0), cA + kstep, voffA); PG8_STAGE(PG8_SB(1, 1), cB + hstep + kstep, voffB);
        PG8_WAIT_V(6); PG8_BAR;
    } else {
        PG8_STAGE(PG8_SB(0, 0), cB, voffB); PG8_STAGE(PG8_SA(0, 0), cA, voffA); PG8_STAGE(PG8_SB(0, 1), cB + hstep, voffB); PG8_STAGE(PG8_SA(0, 1), cA + hstep, voffA);
        if (wr == 1) PG8_BAR;
        PG8_WAIT_V(4); PG8_BAR;
        PG8_STAGE(PG8_SB(1, 0), cB + kstep, voffB); PG8_STAGE(PG8_SA(1, 0), cA + kstep, voffA); PG8_STAGE(PG8_SB(1, 1), cB + hstep + kstep, voffB);
        PG8_WAIT_V(6); PG8_BAR;
    }
    for (;;) {
        const bool has_next = S.next(ui + 1, nxt);
        const char* nA = has_next ? (const char*)g.A + (size_t)nxt.pm * tstep : cA; const char* nB = has_next ? (const char*)g.Bt + (size_t)nxt.pn * tstep : cB;
        for (int t = 0; t < nt; t += 2) {
            const bool last = (t == nt - 2);
            const char* a1 = cA + (size_t)(t + 1) * kstep;
            const char* a2 = last ? nA : cA + (size_t)(t + 2) * kstep; const char* b2 = last ? nB : cB + (size_t)(t + 2) * kstep;
            const char* a3 = a2 + kstep; const char* b3 = b2 + kstep;
            if (last && has_next) S.a_ready(nxt);
            if constexpr (SP2) {
            PG8_LDB(B0, 0, 0); PG8_LDB(B1, 0, 1); PG8_SCHED; PG8_LDA(At, 0, 0); PG8_STAGE(PG8_SA(1, 1), a1 + hstep, voffA);
            PG8_WAIT_V(8); PG8_WAIT_L(0); PG8_BAR; PG8_MMA(0, 0, At, B0); PG8_MMA(0, 1, At, B1); PG8_BAR; PG8_SCHED;
            PG8_LDA(At, 0, 1); PG8_STAGE(PG8_SB(0, 0), b2, voffB); PG8_STAGE(PG8_SB(0, 1), b2 + hstep, voffB); PG8_STAGE(PG8_SA(0, 0), a2, voffA);
            PG8_WAIT_V(8); PG8_WAIT_L(0); PG8_BAR; PG8_MMA(1, 0, At, B0); PG8_MMA(1, 1, At, B1); PG8_BAR; PG8_SCHED;
            PG8_LDB(B0, 1, 0); PG8_LDB(B1, 1, 1); PG8_SCHED; PG8_LDA(At, 1, 0); PG8_STAGE(PG8_SA(0, 1), a2 + hstep, voffA);
            PG8_WAIT_V(8); PG8_WAIT_L(0); PG8_BAR; PG8_MMA(0, 0, At, B0); PG8_MMA(0, 1, At, B1); PG8_BAR; PG8_SCHED;
            PG8_LDA(At, 1, 1); PG8_STAGE(PG8_SB(1, 0), b3, voffB); PG8_STAGE(PG8_SB(1, 1), b3 + hstep, voffB); PG8_STAGE(PG8_SA(1, 0), a3, voffA);
            PG8_WAIT_V(8); PG8_WAIT_L(0); PG8_BAR; PG8_MMA(1, 0, At, B0); PG8_MMA(1, 1, At, B1); PG8_BAR; PG8_SCHED;
            } else {
            PG8_LDB(B0, 0, 0); PG8_SCHED; PG8_LDA(At, 0, 0); PG8_STAGE(PG8_SA(1, 1), a1 + hstep, voffA);
            PG8_WAIT_L(8); PG8_BAR; PG8_WAIT_L(0); PG8_MMA(0, 0, At, B0); PG8_BAR; PG8_SCHED;
            PG8_LDB(B1, 0, 1); PG8_STAGE(PG8_SB(0, 0), b2, voffB);
            PG8_BAR; PG8_WAIT_L(0); PG8_MMA(0, 1, At, B1); PG8_BAR;
            PG8_LDA(At, 0, 1); PG8_STAGE(PG8_SA(0, 0), a2, voffA);
            PG8_BAR; PG8_WAIT_L(0); PG8_MMA(1, 0, At, B0); PG8_BAR; PG8_SCHED;
            PG8_STAGE(PG8_SB(0, 1), b2 + hstep, voffB);
            PG8_WAIT_V(6); PG8_BAR; PG8_MMA(1, 1, At, B1); PG8_BAR;
            PG8_LDB(B0, 1, 0); PG8_SCHED; PG8_LDA(At, 1, 0); PG8_STAGE(PG8_SA(0, 1), a2 + hstep, voffA);
            PG8_WAIT_L(8); PG8_BAR; PG8_WAIT_L(0); PG8_MMA(0, 0, At, B0); PG8_BAR; PG8_SCHED;
            PG8_LDB(B1, 1, 1); PG8_STAGE(PG8_SB(1, 0), b3, voffB);
            PG8_BAR; PG8_WAIT_L(0); PG8_MMA(0, 1, At, B1); PG8_BAR;
            PG8_LDA(At, 1, 1); PG8_STAGE(PG8_SA(1, 0), a3, voffA);
            PG8_BAR; PG8_WAIT_L(0); PG8_MMA(1, 0, At, B0); PG8_BAR; PG8_SCHED;
            PG8_STAGE(PG8_SB(1, 1), b3 + hstep, voffB);
            PG8_WAIT_V(6); PG8_BAR; PG8_MMA(1, 1, At, B1); PG8_BAR;
            }
        }
        if constexpr (ALIGN_EPI) { if (wr == 0) PG8_BAR; }
        if constexpr (!Epi::AFTER_DRAIN) { E(acc, cur, wr, wc, fr, fq); S.done(cur); }
        if (!has_next) break;
#pragma unroll
        for (int a = 0; a < 2; ++a)
#pragma unroll
            for (int b = 0; b < 2; ++b)
#pragma unroll
                for (int m = 0; m < 4; ++m)
#pragma unroll
                    for (int n = 0; n < 2; ++n) acc[a][b][m][n] = (f32x4){0.f, 0.f, 0.f, 0.f};
        cur = nxt; cA = nA; cB = nB; ++ui;
        if constexpr (ALIGN_EPI) { if (wr == 1) PG8_BAR; }
    }
    PG8_WAIT_V(0);
    if constexpr (!ALIGN_EPI) { if (wr == 0) PG8_BAR; }
    PG8_BAR;
    if constexpr (Epi::AFTER_DRAIN) { E.fused(acc, cur, wr, wc, fr, fq, lds, wid, lane); S.done(cur); }
#undef PG8_SA
#undef PG8_SB
#undef PG8_STAGE
#undef PG8_LDA
#undef PG8_LDB
#undef PG8_MMA
#undef PG8_WAIT_V
#undef PG8_WAIT_L
#undef PG8_BAR
#undef PG8_SCHED
}
}
#define PG8_DONE 1
namespace att {
typedef unsigned short bf16_t;
typedef short bf16x8 __attribute__((ext_vector_type(8)));
typedef float f32x16 __attribute__((ext_vector_type(16)));
typedef float f32x4 __attribute__((ext_vector_type(4)));
typedef unsigned u32x4 __attribute__((ext_vector_type(4)));
typedef unsigned u32x2 __attribute__((ext_vector_type(2)));
#define ATT_LAS __attribute__((address_space(3)))
#define ATT_MFMA(a, b, c) __builtin_amdgcn_mfma_f32_32x32x16_bf16((a), (b), (c), 0, 0, 0)
using pg8::pkbf;
constexpr float RTHR = 8.0f;

template <int NDV>
__device__ __forceinline__ void softmax_step(f32x16& s, float& m, float& l, f32x16 (&o)[NDV], bf16x8 (&pf)[2]) {
    float mx = fmaxf(fmaxf(s[0], s[1]), fmaxf(s[2], s[3]));
#pragma unroll
    for (int t = 4; t < 16; t += 4) mx = fmaxf(mx, fmaxf(fmaxf(s[t], s[t + 1]), fmaxf(s[t + 2], s[t + 3])));
    mx = fmaxf(mx, __shfl_xor(mx, 32));
    const bool grow = mx > m + RTHR;
    if (__any(grow)) {
        const float mn = grow ? mx : m;
        const float alpha = __builtin_amdgcn_exp2f(m - mn);
        m = mn; l *= alpha;
#pragma unroll
        for (int d = 0; d < NDV; ++d)
#pragma unroll
            for (int t = 0; t < 16; ++t) o[d][t] *= alpha;
    }
    float ls = 0.f;
#pragma unroll
    for (int t = 0; t < 16; ++t) { s[t] = __builtin_amdgcn_exp2f(s[t] - m); ls += s[t]; }
    l += ls;
#pragma unroll
    for (int s2 = 0; s2 < 2; ++s2) { u32x4 w; w.x = pkbf(s[8 * s2], s[8 * s2 + 1]); w.y = pkbf(s[8 * s2 + 2], s[8 * s2 + 3]); w.z = pkbf(s[8 * s2 + 4], s[8 * s2 + 5]); w.w = pkbf(s[8 * s2 + 6], s[8 * s2 + 7]);
        pf[s2] = __builtin_bit_cast(bf16x8, w); }
}
__device__ __forceinline__ void softmax_step_nomax(f32x16& s, float& l, bf16x8 (&pf)[2]) {
    float ls0 = 0.f, ls1 = 0.f, ls2 = 0.f, ls3 = 0.f;
#pragma unroll
    for (int t = 0; t < 16; t += 4) { s[t] = __builtin_amdgcn_exp2f(s[t]); s[t + 1] = __builtin_amdgcn_exp2f(s[t + 1]); s[t + 2] = __builtin_amdgcn_exp2f(s[t + 2]); s[t + 3] = __builtin_amdgcn_exp2f(s[t + 3]);
        ls0 += s[t]; ls1 += s[t + 1]; ls2 += s[t + 2]; ls3 += s[t + 3]; }
    l += (ls0 + ls1) + (ls2 + ls3);
#pragma unroll
    for (int s2 = 0; s2 < 2; ++s2) { u32x4 w; w.x = pkbf(s[8 * s2], s[8 * s2 + 1]); w.y = pkbf(s[8 * s2 + 2], s[8 * s2 + 3]); w.z = pkbf(s[8 * s2 + 4], s[8 * s2 + 5]); w.w = pkbf(s[8 * s2 + 6], s[8 * s2 + 7]);
        pf[s2] = __builtin_bit_cast(bf16x8, w); }
}
__device__ __forceinline__ void store_a(const f32x16 (&o)[2], float inv, bf16_t* yrow, int h, bool valid) {
    if (!valid) return;
#pragma unroll
    for (int d = 0; d < 2; ++d)
#pragma unroll
        for (int g = 0; g < 4; ++g) { u32x2 w; w.x = pkbf(o[d][4 * g] * inv, o[d][4 * g + 1] * inv); w.y = pkbf(o[d][4 * g + 2] * inv, o[d][4 * g + 3] * inv); *(u32x2*)(yrow + 32 * d + 8 * g + 4 * h) = w; }
}
__device__ __forceinline__ void finish_b(f32x16 (&o1)[4], const f32x16 (&o2)[4], float i1, float i2l, const float* subg, bf16_t* yrow, int h, bool valid) {
    float ss = 0.f;
#pragma unroll
    for (int d = 0; d < 4; ++d)
#pragma unroll
        for (int t = 0; t < 16; ++t) { const float v = o1[d][t] * i1 - i2l * o2[d][t]; o1[d][t] = v; ss += v * v; }
    ss += __shfl_xor(ss, 32);
    const float sc = (1.0f / sqrtf(ss * (1.0f / 128.0f) + EPSN)) * 0.8f;
    if (!valid) return;
#pragma unroll
    for (int d = 0; d < 4; ++d)
#pragma unroll
        for (int g = 0; g < 4; ++g) { const int e0 = 32 * d + 8 * g + 4 * h; const f32x4 gg = *(const f32x4*)(subg + e0);
            u32x2 w; w.x = pkbf(o1[d][4 * g] * sc * gg[0], o1[d][4 * g + 1] * sc * gg[1]); w.y = pkbf(o1[d][4 * g + 2] * sc * gg[2], o1[d][4 * g + 3] * sc * gg[3]); *(u32x2*)(yrow + e0) = w;
            asm volatile("" ::: "memory"); }
}

template <int NR, int NDV, bool BIAS>
__device__ __forceinline__ void wg_attn(const bf16_t* __restrict__ Qg, const bf16_t* __restrict__ Kg, const bf16_t* __restrict__ VTg, int qb, ATT_LAS unsigned char* L, const ATT_LAS float* tbl,
                                        float lam, const float* subg, bf16_t* yout) {
    int tid = threadIdx.x; asm volatile("" : "+v"(tid));
    const int lane = tid & 63, w = __builtin_amdgcn_readfirstlane(tid >> 6), r = lane & 31, h = lane >> 5;
    const int pr = (r & 0x13) | ((r & 4) << 1) | ((r & 8) >> 1);
    const int swk = (pr >> 1) & 7, swv = (r >> 1) & 7;
    const int cw = qb * 4 + (w >> 1);
    const int tstart = BIAS ? (qb * 4 > 8 ? qb * 4 - 8 : 0) : 0;
    const int T = qb * 4 + 4 - tstart;
    const int srow = qb * 256 + w * 32 + r;
    constexpr int KT = 8192, VTB = NDV * 32 * 128, STAGE = NR * KT + VTB;
    bf16x8 qf[NR][4];
#pragma unroll
    for (int rr = 0; rr < NR; ++rr)
#pragma unroll
        for (int ds = 0; ds < 4; ++ds) qf[rr][ds] = *(const bf16x8*)(Qg + ((size_t)rr * 2048 + srow) * 64 + 16 * ds + 8 * h);
    f32x16 o[NR][NDV]; float m[NR], l[NR];
#pragma unroll
    for (int rr = 0; rr < NR; ++rr) { m[rr] = -INFINITY; l[rr] = 0.f;
#pragma unroll
        for (int d = 0; d < NDV; ++d)
#pragma unroll
            for (int t = 0; t < 16; ++t) o[rr][d][t] = 0.f; }
    const int rl = lane >> 3, slot = lane & 7;
#define ATT_DMA(t_, buf_) do { const int ct_ = tstart + (t_); ATT_LAS unsigned char* sb_ = L + (buf_) * STAGE; \
        _Pragma("unroll") for (int i_ = 0; i_ < NR; ++i_) { const int row_ = w * 8 + rl; const int c_ = slot ^ ((row_ >> 1) & 7); \
            __builtin_amdgcn_global_load_lds((const unsigned*)(Kg + ((size_t)i_ * 2048 + ct_ * 64 + row_) * 64 + c_ * 8), (ATT_LAS unsigned*)(sb_ + i_ * KT + w * 1024), 16, 0, 0); } \
        _Pragma("unroll") for (int i_ = 0; i_ < NDV / 2; ++i_) { const int d_ = (w + 8 * i_) * 8 + rl; const int c_ = slot ^ ((d_ >> 1) & 7); \
            __builtin_amdgcn_global_load_lds((const unsigned*)(VTg + (size_t)d_ * 2048 + ct_ * 64 + c_ * 8), (ATT_LAS unsigned*)(sb_ + NR * KT + (w + 8 * i_) * 1024), 16, 0, 0); } } while (0)
    constexpr int NST = (NR == 1) ? 4 : 3, LPG = NR + NDV / 2;
    static_assert(NST * STAGE <= 131072 && (NST - 2) * LPG == 4, "ring fits the phase scratch; the wait below is vmcnt(4)");
    asm volatile("s_waitcnt vmcnt(0)" ::: "memory");
#pragma unroll
    for (int i = 0; i < NST - 1; ++i) { const int ti = i < T ? i : T - 1; ATT_DMA(ti, i); }
    int cslot = 0, fslot = NST - 1;
    for (int t = 0; t < T; ++t) {
        asm volatile("s_waitcnt vmcnt(4)" ::: "memory");
        __builtin_amdgcn_s_barrier();
        asm volatile("" ::: "memory");
        { const int tn = t + NST - 1 < T ? t + NST - 1 : T - 1; ATT_DMA(tn, fslot); }
        const int ct = tstart + t;
        const bool vis = BIAS ? (ct >= cw - 8 && ct <= cw) : (ct <= cw);
        if (vis) {
            const ATT_LAS unsigned char* sb = L + cslot * STAGE;
            if constexpr (NR == 1) {
                f32x16 sv[2]; bf16x8 pf2[2][2];
#pragma unroll
                for (int kb2 = 0; kb2 < 2; ++kb2) {
#pragma unroll
                    for (int t2 = 0; t2 < 16; ++t2) sv[kb2][t2] = 0.f;
#pragma unroll
                    for (int ds = 0; ds < 4; ++ds) { const bf16x8 kf = *(const ATT_LAS bf16x8*)(sb + (kb2 * 32 + pr) * 128 + (((2 * ds + h) ^ swk) << 4)); sv[kb2] = ATT_MFMA(kf, qf[0][ds], sv[kb2]); }
                }
#pragma unroll
                for (int kb2 = 0; kb2 < 2; ++kb2) {
                    f32x16& s = sv[kb2];
                    if (BIAS) {
                        const int kbase = ct * 64 + kb2 * 32;
                        if (qb * 256 + w * 32 - (kbase + 31) >= 256) {
                            const float cb = tbl[319];
#pragma unroll
                            for (int t2 = 0; t2 < 16; ++t2) s[t2] += cb;
                        } else {
                            const ATT_LAS float* tb = tbl + (srow - kbase - 8 * h + 40);
#pragma unroll
                            for (int t2 = 0; t2 < 16; ++t2) s[t2] += tb[23 - (16 * (t2 >> 3) + (t2 & 7))];
                        }
                    }
                    softmax_step_nomax(s, l[0], pf2[kb2]);
#pragma unroll
                    for (int d = 0; d < NDV; ++d)
#pragma unroll
                        for (int s2 = 0; s2 < 2; ++s2) { const bf16x8 vf = *(const ATT_LAS bf16x8*)(sb + KT + (d * 32 + r) * 128 + (((4 * kb2 + 2 * s2 + h) ^ swv) << 4));
                            o[0][d] = ATT_MFMA(vf, pf2[kb2][s2], o[0][d]); }
                }
            } else
#pragma unroll 1
            for (int kb2 = 0; kb2 < 2; ++kb2) {
                bf16x8 pf[NR][2];
#pragma unroll
                for (int rr = 0; rr < NR; ++rr) {
                    f32x16 s;
#pragma unroll
                    for (int t2 = 0; t2 < 16; ++t2) s[t2] = 0.f;
#pragma unroll
                    for (int ds = 0; ds < 4; ++ds) { const bf16x8 kf = *(const ATT_LAS bf16x8*)(sb + rr * KT + (kb2 * 32 + pr) * 128 + (((2 * ds + h) ^ swk) << 4)); s = ATT_MFMA(kf, qf[rr][ds], s); }
                    if (BIAS) {
                        const int kbase = ct * 64 + kb2 * 32;
                        if (qb * 256 + w * 32 - (kbase + 31) >= 256) {
                            const float cb = tbl[319];
#pragma unroll
                            for (int t2 = 0; t2 < 16; ++t2) s[t2] += cb;
                        } else {
                            const ATT_LAS float* tb = tbl + (srow - kbase - 8 * h + 40);
#pragma unroll
                            for (int t2 = 0; t2 < 16; ++t2) s[t2] += tb[23 - (16 * (t2 >> 3) + (t2 & 7))];
                        }
                    }
                    if constexpr (NR == 2) softmax_step_nomax(s, l[rr], pf[rr]); else softmax_step<NDV>(s, m[rr], l[rr], o[rr], pf[rr]);
                }
                __builtin_amdgcn_s_setprio(1);
#pragma unroll
                for (int d = 0; d < NDV; ++d)
#pragma unroll
                    for (int s2 = 0; s2 < 2; ++s2) { const bf16x8 vf = *(const ATT_LAS bf16x8*)(sb + NR * KT + (d * 32 + r) * 128 + (((4 * kb2 + 2 * s2 + h) ^ swv) << 4));
#pragma unroll
                        for (int rr = 0; rr < NR; ++rr) o[rr][d] = ATT_MFMA(vf, pf[rr][s2], o[rr][d]); }
                __builtin_amdgcn_s_setprio(0);
            }
        }
        asm volatile("s_waitcnt lgkmcnt(0)" ::: "memory");
        cslot = (cslot == NST - 1) ? 0 : cslot + 1; fslot = (fslot == NST - 1) ? 0 : fslot + 1;
    }
    asm volatile("s_waitcnt vmcnt(0)" ::: "memory");
    __builtin_amdgcn_s_barrier();
    asm volatile("" ::: "memory");
#undef ATT_DMA
#pragma unroll
    for (int rr = 0; rr < NR; ++rr) { l[rr] += __shfl_xor(l[rr], 32); l[rr] = 1.0f / l[rr]; }
    if constexpr (NR == 1) store_a(o[0], l[0], yout + (size_t)srow * 512, h, true);
    else finish_b(o[0], o[1], l[0], lam * l[1], subg, yout + (size_t)srow * 512, h, true);
}

template <int NDV, bool BIAS>
__device__ __forceinline__ void attn_part(const bf16_t* __restrict__ q, const bf16_t* __restrict__ k, const bf16_t* __restrict__ vt, int vpitch, const float* __restrict__ kc, const float* __restrict__ vc, int ncb,
                                          int kb0, int kstep, int nkb, int nvalid, int dq, const ATT_LAS float* tbl, f32x16 (&o)[NDV], float& mout, float& lout, int lane_) {
    int lane = lane_; asm volatile("" : "+v"(lane));
    const int r = lane & 31, h = lane >> 5;
    const int pr = (r & 0x13) | ((r & 4) << 1) | ((r & 8) >> 1);
    bf16x8 qf[4];
#pragma unroll
    for (int ds = 0; ds < 4; ++ds) qf[ds] = *(const bf16x8*)(q + 16 * ds + 8 * h);
#pragma unroll
    for (int d = 0; d < NDV; ++d)
#pragma unroll
        for (int t = 0; t < 16; ++t) o[d][t] = 0.f;
    float mrun = -INFINITY, lrun = 0.f;
    const bf16_t* kp = k + pr * 64 + 8 * h;
    const bf16_t* vp = vt + (size_t)r * vpitch + 8 * h;
    const float* kcp = kc + (size_t)pr * 512 + 8 * h;
    const float* vcp = vc + (size_t)(8 * h) * 512 + r;
    for (int kb = kb0; kb < nkb; kb += kstep) {
        bf16x8 kf[4], vf[NDV][2];
        if (kb < ncb) {
            f32x4 kr[4][2];
#pragma unroll
            for (int ds = 0; ds < 4; ++ds) { kr[ds][0] = *(const f32x4*)(kcp + (size_t)kb * 32 * 512 + 16 * ds); kr[ds][1] = *(const f32x4*)(kcp + (size_t)kb * 32 * 512 + 16 * ds + 4); }
#pragma unroll
            for (int d = 0; d < NDV; ++d)
#pragma unroll
                for (int s2 = 0; s2 < 2; ++s2) { float vr[8];
#pragma unroll
                    for (int j = 0; j < 8; ++j) vr[j] = vcp[(size_t)(kb * 32 + 16 * s2 + j) * 512 + 32 * d];
                    u32x4 w; w.x = pkbf(vr[0], vr[1]); w.y = pkbf(vr[2], vr[3]); w.z = pkbf(vr[4], vr[5]); w.w = pkbf(vr[6], vr[7]); vf[d][s2] = __builtin_bit_cast(bf16x8, w); }
#pragma unroll
            for (int ds = 0; ds < 4; ++ds) { u32x4 w; w.x = pkbf(kr[ds][0][0], kr[ds][0][1]); w.y = pkbf(kr[ds][0][2], kr[ds][0][3]); w.z = pkbf(kr[ds][1][0], kr[ds][1][1]); w.w = pkbf(kr[ds][1][2], kr[ds][1][3]); kf[ds] = __builtin_bit_cast(bf16x8, w); }
        } else {
#pragma unroll
            for (int ds = 0; ds < 4; ++ds) kf[ds] = *(const bf16x8*)(kp + (size_t)kb * 2048 + 16 * ds);
#pragma unroll
            for (int d = 0; d < NDV; ++d)
#pragma unroll
                for (int s2 = 0; s2 < 2; ++s2) vf[d][s2] = *(const bf16x8*)(vp + (size_t)d * 32 * vpitch + kb * 32 + 16 * s2);
        }
        f32x16 s;
#pragma unroll
        for (int t = 0; t < 16; ++t) s[t] = 0.f;
#pragma unroll
        for (int ds = 0; ds < 4; ++ds) s = ATT_MFMA(kf[ds], qf[ds], s);
        const int key0 = kb * 32 + 8 * h;
        if (BIAS) {
#pragma unroll
            for (int t = 0; t < 16; ++t) s[t] += tbl[dq - (key0 + 16 * (t >> 3) + (t & 7)) + 63];
        }
        if ((kb + 1) * 32 > nvalid) {
#pragma unroll
            for (int t = 0; t < 16; ++t) if (key0 + 16 * (t >> 3) + (t & 7) >= nvalid) s[t] = -INFINITY;
        }
        bf16x8 pf[2];
        softmax_step<NDV>(s, mrun, lrun, o, pf);
#pragma unroll
        for (int d = 0; d < NDV; ++d)
#pragma unroll
            for (int s2 = 0; s2 < 2; ++s2) o[d] = ATT_MFMA(vf[d][s2], pf[s2], o[d]);
    }
    lrun += __shfl_xor(lrun, 32);
    mout = mrun; lout = lrun;
}
template <int NDV>
__device__ __forceinline__ void combine8(f32x16 (&o)[NDV], float m, float l, ATT_LAS float* po  , ATT_LAS float* pml  , int w, int lane) {
    if (w > 0) {
        ATT_LAS float* pw = po + (w - 1) * NDV * 16 * 64 + lane; asm volatile("" : "+v"(pw));
#pragma unroll
        for (int d = 0; d < NDV; ++d)
#pragma unroll
            for (int t = 0; t < 16; ++t) pw[(d * 16 + t) * 64] = o[d][t];
    }
    pml[w * 128 + lane] = m; pml[w * 128 + 64 + lane] = l;
    __syncthreads();
    if (w == 0) {
        float M = pml[lane], Ls = 0.f;
#pragma unroll
        for (int i = 1; i < 8; ++i) M = fmaxf(M, pml[i * 128 + lane]);
#pragma unroll
        for (int i = 0; i < 8; ++i) Ls += pml[i * 128 + 64 + lane] * __builtin_amdgcn_exp2f(pml[i * 128 + lane] - M);
        const float inv = 1.0f / Ls;
        const float e0 = __builtin_amdgcn_exp2f(m - M) * inv;
#pragma unroll
        for (int d = 0; d < NDV; ++d)
#pragma unroll
            for (int t = 0; t < 16; ++t) o[d][t] *= e0;
#pragma unroll 1
        for (int i = 1; i < 8; ++i) {
            const float ei = __builtin_amdgcn_exp2f(pml[i * 128 + lane] - M) * inv;
            const ATT_LAS float* pi = po + (i - 1) * NDV * 16 * 64 + lane; asm volatile("" : "+v"(pi));
#pragma unroll
            for (int d = 0; d < NDV; ++d)
#pragma unroll
                for (int t = 0; t < 16; ++t) o[d][t] += pi[(d * 16 + t) * 64] * ei;
        }
    }
    __syncthreads();
}
}

#define LAS __attribute__((address_space(3)))
typedef unsigned short bf16;
typedef unsigned v4u __attribute__((ext_vector_type(4)));
typedef float f32x4 __attribute__((ext_vector_type(4)));
constexpr int NWAVES = 8;
constexpr int RING_BYTES = 131072, TBL_OFF = RING_BYTES, TBL_N = 640, PML_OFF = TBL_OFF + 8 * TBL_N * 4, BST_OFF = PML_OFF + 4096, LDS_BYTES = 157696;

struct Args { const float* in[26]; float* out; unsigned char* ws; };
enum { I_XP = 0, I_XS, I_CAK, I_CAV, I_CBK, I_CBV, I_LN1, I_WIN, I_QNA, I_KNA, I_REL, I_QNB, I_KNB, I_LQ1, I_LK1, I_LQ2, I_LK2, I_SUBG, I_WG, I_BG, I_WPA, I_WPB, I_WOUT, I_LN2, I_WFF1, I_WFF2 };

__device__ __forceinline__ float wave_sum(float v) {
#pragma unroll
    for (int o = 1; o < 64; o <<= 1) v += __shfl_xor(v, o);
    return v;
}
__device__ __forceinline__ void tr_item(const float* W, int ldw, bf16* WT, int ldt, int k0, int n0, int rowbase, LAS float* scr, int lane, const float* kscale = nullptr) {
    float tv[32];
#pragma unroll
    for (int i = 0; i < 32; ++i) { const int kk = 2 * i + (lane >> 5); tv[i] = W[(size_t)(k0 + kk) * ldw + n0 + (lane & 31)]; }
#pragma unroll
    for (int i = 0; i < 32; ++i) { const int kk = 2 * i + (lane >> 5); scr[kk * 33 + (lane & 31)] = kscale ? tv[i] * kscale[k0 + kk] : tv[i]; }
    asm volatile("s_waitcnt lgkmcnt(0)" ::: "memory");
    const int c = lane & 7;
#pragma unroll
    for (int j = 0; j < 4; ++j) { const int n = (lane >> 3) + 8 * j; const LAS float* s = scr + (8 * c) * 33 + n;
        v4u o; o.x = pg8::pkbf(s[0 * 33], s[1 * 33]); o.y = pg8::pkbf(s[2 * 33], s[3 * 33]); o.z = pg8::pkbf(s[4 * 33], s[5 * 33]); o.w = pg8::pkbf(s[6 * 33], s[7 * 33]);
        *(v4u*)(WT + (size_t)(rowbase + n) * ldt + k0 + 8 * c) = o; }
    asm volatile("s_waitcnt lgkmcnt(0)" ::: "memory");
}
__device__ __forceinline__ int permrow(int c) { return (c & ~255) + ((c >> 5) & 1) * 128 + ((c >> 6) & 3) * 32; }

#define XB_TMO      128
#define XB_XCNT(j)  (256  + 64 * (j))
#define XB_XSUB(j)  (1280 + 64 * (j))
#define XB_XGEN(j)  (2304 + 64 * (j))
#define XB_TOP      3328
#define XB_TOPGEN   3392
#define XCD_BAR_WORDS 3456
#define XB_SPIN_CAP (1u << 18)

__device__ __forceinline__ unsigned xb_ld(unsigned* p)              { return __hip_atomic_load(p, __ATOMIC_RELAXED, __HIP_MEMORY_SCOPE_AGENT); }
__device__ __forceinline__ unsigned xb_add(unsigned* p, unsigned v) { return __hip_atomic_fetch_add(p, v, __ATOMIC_RELAXED, __HIP_MEMORY_SCOPE_AGENT); }
__device__ __forceinline__ unsigned xb_xcc_id() { return (unsigned)__builtin_amdgcn_s_getreg((3 << 11) | 20) & 0xFu; }
#define XB_SPIN(cond, bar) do { unsigned _sp = 0; while (cond) { __builtin_amdgcn_s_sleep(1); \
    if ((++_sp & 255u) == 0u) { if (xb_ld(&(bar)[XB_TMO])) break; if (_sp > XB_SPIN_CAP) { atomicAdd(&(bar)[XB_TMO], 1u); break; } } } } while (0)

struct XcdBarrier {
    unsigned* bar; unsigned x;
    volatile LAS unsigned* st;
};

__device__ __forceinline__ XcdBarrier xcd_barrier_post(unsigned* bar, volatile LAS unsigned* st) {
    XcdBarrier b; b.bar = bar; b.x = xb_xcc_id(); b.st = st;
    if (threadIdx.x == 0) (void)xb_add(&bar[XB_XCNT(b.x)], 1u);
    return b;
}
__device__ __forceinline__ void xcd_barrier_complete(unsigned* bar, unsigned x, unsigned& nloc, unsigned& nx) {
    const unsigned G = gridDim.x * gridDim.y * gridDim.z;
    unsigned sum, cnt, mine, sp = 0u;
    for (;;) {
        sum = 0u; cnt = 0u; mine = 0u;
#pragma unroll
        for (unsigned j = 0; j < 16; ++j) { const unsigned c = xb_ld(&bar[XB_XCNT(j)]); sum += c; cnt += (c > 0u) ? 1u : 0u; mine = (j == x) ? c : mine; }
        if (sum == G) break;
        __builtin_amdgcn_s_sleep(1);
        if ((++sp & 255u) == 0u) { if (xb_ld(&bar[XB_TMO])) break; if (sp > XB_SPIN_CAP) { atomicAdd(&bar[XB_TMO], 1u); break; } }
    }
    nloc = mine > 0u ? mine : 1u; nx = cnt > 0u ? cnt : 1u;
}

__device__ __forceinline__ void xcd_barrier(const XcdBarrier& b) {
    asm volatile("s_waitcnt vmcnt(0)" ::: "memory");
    __syncthreads();
    if (threadIdx.x == 0) {
        unsigned* bar = b.bar;
        __builtin_amdgcn_s_waitcnt(0);
        unsigned nloc = b.st[0], nx = b.st[1];
        if (nloc == 0u) { xcd_barrier_complete(bar, b.x, nloc, nx); b.st[0] = nloc; b.st[1] = nx; }
        const unsigned old = xb_add(&bar[XB_XSUB(b.x)], 1u);
        const unsigned gen = old / nloc;
        if (old + 1u == (gen + 1u) * nloc) {
            __builtin_amdgcn_fence(__ATOMIC_RELEASE, "agent");
            asm volatile("s_waitcnt vmcnt(0)" ::: "memory");
            const unsigned og = xb_add(&bar[XB_TOP], 1u);
            const unsigned tg = og / nx;
            if (og + 1u == (tg + 1u) * nx) xb_add(&bar[XB_TOPGEN], 1u);
            else XB_SPIN(xb_ld(&bar[XB_TOPGEN]) == tg, bar);
            __builtin_amdgcn_fence(__ATOMIC_ACQUIRE, "agent");
            xb_add(&bar[XB_XGEN(b.x)], 1u);
            asm volatile("s_waitcnt vmcnt(0)" ::: "memory");
        } else {
            XB_SPIN(xb_ld(&bar[XB_XGEN(b.x)]) == gen, bar);
            __builtin_amdgcn_fence(__ATOMIC_ACQUIRE, "agent");
            asm volatile("s_waitcnt vmcnt(0)" ::: "memory");
        }
    }
    __syncthreads();
}

__global__ void __launch_bounds__(NWAVES * 64, 2) mega_fwd(Args args) {
    extern __shared__ __attribute__((aligned(16))) unsigned char lds[];
    cg::grid_group grid = cg::this_grid();
    LAS unsigned char* L = (LAS unsigned char*)lds;
    const int tid = threadIdx.x, lane = tid & 63, wave = __builtin_amdgcn_readfirstlane(tid >> 6);
    const int G = gridDim.x, bx = blockIdx.x;
    const int vcu = (G % 8 == 0) ? (bx % 8) * (G / 8) + bx / 8 : bx;
    const int gw = vcu * NWAVES + wave, NGW = G * NWAVES;
    unsigned char* ws = args.ws; float* out = args.out;
    volatile LAS unsigned* bst = (volatile LAS unsigned*)(L + BST_OFF);
    if (threadIdx.x < 2) bst[threadIdx.x] = 0u;
    for (int i = gw * 64 + lane; i < XCD_BAR_WORDS + 64; i += NGW * 64) ((unsigned*)(ws + WS_BAR))[i] = 0u;
    __syncthreads();
    grid.sync();
    const XcdBarrier xbar = xcd_barrier_post((unsigned*)(ws + WS_BAR), bst);

    {
        LAS float* scr = (LAS float*)(L + wave * 16384);
        constexpr int N_WIN = 16 * 96, N_WG = 16 * 64;
        for (int it = gw; it < N_WIN + N_WG; it += NGW) {
            int r = it;
            if (r < N_WIN) { const int kb = r / 96, nb = r % 96; tr_item(args.in[I_WIN], 3072, (bf16*)(ws + WS_WIN), 1024, kb * 64, nb * 32, permrow(nb * 32), scr, lane); continue; } r -= N_WIN;
            { const int kb = r / 64, nb = r % 64; tr_item(args.in[I_WG], 2048, (bf16*)(ws + WS_WIN), 1024, kb * 64, nb * 32, permrow(3072 + nb * 32), scr, lane); }
        }
        {
            const f32x4* gp = (const f32x4*)args.in[I_LN1] + lane; f32x4 gv[4];
#pragma unroll
            for (int j = 0; j < 4; ++j) gv[j] = gp[64 * j];
            for (int row0 = gw; row0 < MROWS; row0 += 4 * NGW) {
                f32x4 v[4][4];
#pragma unroll
                for (int q = 0; q < 4; ++q) { const int row = row0 + q * NGW;
                    if (row < MROWS) { const float* xr = row < 32768 ? args.in[I_XP] + (size_t)row * 1024 : args.in[I_XS] + (size_t)(row - 32768) * 1024;
                        const f32x4* xp4 = (const f32x4*)xr + lane;
#pragma unroll
                        for (int j = 0; j < 4; ++j) v[q][j] = xp4[64 * j]; } }
#pragma unroll
                for (int q = 0; q < 4; ++q) { const int row = row0 + q * NGW;
                    if (row < MROWS) { float s = 0.f;
#pragma unroll
                        for (int j = 0; j < 4; ++j) s += (v[q][j][0] * v[q][j][0] + v[q][j][1] * v[q][j][1]) + (v[q][j][2] * v[q][j][2] + v[q][j][3] * v[q][j][3]);
                        const float rms = sqrtf(wave_sum(s) * (1.0f / 1024.0f) + EPSN); const float rstd = 1.0f / rms;
                        if (lane == 0) ((float*)(ws + WS_RINV))[row] = rms;
                        unsigned long long* o8 = (unsigned long long*)((bf16*)(ws + WS_H) + (size_t)row * 1024) + lane;
#pragma unroll
                        for (int j = 0; j < 4; ++j) { const f32x4 y = v[q][j] * rstd * gv[j]; o8[64 * j] = (unsigned long long)pg8::pkbf(y[0], y[1]) | ((unsigned long long)pg8::pkbf(y[2], y[3]) << 32); } } }
            }
        }
        {
            const int gt = gw * 64 + lane, NT = NGW * 64;
            for (int i = gt; i < 8192 * 2; i += NT) { const int row = i >> 1, hf = i & 1;
                *(v4u*)((bf16*)(ws + WS_VAST) + (size_t)row * SPA + 528 + 8 * hf) = (v4u){0u, 0u, 0u, 0u};
                *(v4u*)((bf16*)(ws + WS_VBST) + (size_t)row * SPB + 1040 + 8 * hf) = (v4u){0u, 0u, 0u, 0u}; }
            for (int i = gt; i < 2048 * 32; i += NT) { const int pos = i >> 5, d = i & 31;
                const float inv_freq = exp2f(-(float)d * (13.287712379549449f / 32.0f));
                const float ang = (float)pos * inv_freq;
                const double rev = (double)ang * 0.15915494309189535; const float fr = (float)(rev - __builtin_rint(rev));
                ((float*)(ws + WS_COS))[i] = __builtin_amdgcn_cosf(fr); ((float*)(ws + WS_SIN))[i] = __builtin_amdgcn_sinf(fr); }
            for (int i = gt; i < MROWS; i += NT) ((float*)(ws + WS_SSQ))[i] = 0.f;
        }
    }
    xcd_barrier(xbar);

    {
        pg8::Gemm g{(const pg8::bf16_t*)(ws + WS_H), (const pg8::bf16_t*)(ws + WS_WIN), MROWS, 5120, 1024, 1024}; pg8::StaticOrder S; S.init(MROWS, 5120, G, bx);
        pg8::EpiP1 E{ws, out, args.in[I_QNA], args.in[I_KNA], args.in[I_QNB], args.in[I_KNB], args.in[I_BG]};
        pg8::gemm_phase<pg8::EpiP1, pg8::StaticOrder, true, true>(L, g, S, E);
        {
            const int lane2 = lane_id();
            LAS float* scr = (LAS float*)(L + wave * 16384);
            constexpr int N_PA = 8 * 32, N_PB = 8 * 32, N_WO = 16 * 32, N_F1 = 16 * 128, N_F2 = 64 * 32;
            constexpr int NDEF = N_PA + N_PB + N_WO + N_F1 + N_F2;
            const int rem = (129 * 20) % G, nidle = (G - rem) * NWAVES;
            if (bx >= rem)
            for (int it = (bx - rem) * NWAVES + wave; it < NDEF; it += nidle) {
                int r = it;
                if (r < N_PA) { const int kb = r / 32, nb = r % 32; tr_item(args.in[I_WPA], 1024, (bf16*)(ws + WS_WPA), 512, kb * 64, nb * 32, permrow(nb * 32), scr, lane2); continue; } r -= N_PA;
                if (r < N_PB) { const int kb = r / 32, nb = r % 32; tr_item(args.in[I_WPB], 1024, (bf16*)(ws + WS_WPB), 512, kb * 64, nb * 32, permrow(nb * 32), scr, lane2); continue; } r -= N_PB;
                if (r < N_WO) { const int kb = r / 32, nb = r % 32; tr_item(args.in[I_WOUT], 1024, (bf16*)(ws + WS_WOUT), 1024, kb * 64, nb * 32, permrow(nb * 32), scr, lane2); continue; } r -= N_WO;
                if (r < N_F1) { const int kb = r / 128, nb = r % 128; tr_item(args.in[I_WFF1], 4096, (bf16*)(ws + WS_WFF1), 1024, kb * 64, nb * 32, permrow(nb * 32), scr, lane2, args.in[I_LN2]); continue; } r -= N_F1;
                if (r < N_F2) { const int kb = r / 32, nb = r % 32; tr_item(args.in[I_WFF2], 1024, (bf16*)(ws + WS_WFF2), 4096, kb * 64, nb * 32, permrow(nb * 32), scr, lane2); }
            }
        }
    }
    xcd_barrier(xbar);

    {
        int tid2 = threadIdx.x; asm volatile("" : "+v"(tid2));
        const int tid = tid2, lane = tid & 63, wave = __builtin_amdgcn_readfirstlane(tid >> 6);
        LAS float* tbl = (LAS float*)(L + TBL_OFF);
        LAS float* pml = (LAS float*)(L + PML_OFF);
        for (int i = tid; i < 8 * TBL_N; i += NWAVES * 64) { const int hh = i / TBL_N, j = i % TBL_N; tbl[i] = args.in[I_REL][hh * 320 + (j < 319 ? j : 319)] * LOG2E; }
        __syncthreads();
        const float d1 = wave_sum(args.in[I_LQ1][lane] * args.in[I_LK1][lane]), d2 = wave_sum(args.in[I_LQ2][lane] * args.in[I_LK2][lane]);
        const float lam = __expf(d1) - __expf(d2) + 0.2f;
        const int r = lane & 31, h = lane >> 5;
        const float* subg = args.in[I_SUBG];
        const att::bf16_t* Qa = (const att::bf16_t*)(ws + WS_QKV), *Ka = Qa + 16 * MiB, *VaT = Qa + 32 * MiB, *Qb = Qa + 48 * MiB, *Kb = Qa + 64 * MiB, *VbT = Qa + 80 * MiB;
        att::bf16_t* ya = (att::bf16_t*)(ws + WS_YA); att::bf16_t* yb = (att::bf16_t*)(ws + WS_YB);
        for (int p = vcu; p < 256; p += G) {
            const int bh = p >> 2, i = p & 3;
            for (int j = 0; j < 2; ++j) {
                const int qb = j ? 7 - i : i;
                att::wg_attn<2, 4, false>(Qb + (size_t)bh * 2 * 2048 * 64, Kb + (size_t)bh * 2 * 2048 * 64, VbT + (size_t)bh * 128 * 2048, qb, L, tbl, lam, subg,
                                          yb + (size_t)(bh >> 2) * 2048 * 512 + (bh & 3) * 128);
            }
        }
        const bool bal = (G == 256);
        for (int p = vcu; p < 256; p += G) {
            const int nj = (bal && p >= 128 && p < 192) ? 3 : ((bal && p >= 192) ? 5 : 4);
            for (int j = 0; j < nj; ++j) {
                const int ps = j < 4 ? p : p - 64, jj = j < 4 ? j : 3;
                const int bh = ps >> 1, qb = (ps & 1) + 2 * jj;
                att::wg_attn<1, 2, true>(Qa + (size_t)bh * 2048 * 64, Ka + (size_t)bh * 2048 * 64, VaT + (size_t)bh * 64 * 2048, qb, L, tbl + (bh & 7) * TBL_N, 0.f, subg,
                                         ya + (size_t)(bh >> 3) * 2048 * 512 + (bh & 7) * 64);
            }
        }
        for (int p = vcu; p < 192; p += G) {
            const int tq = r & 15;
            if (p < 128) {
                const int bh = p; att::f32x16 o[2]; float mm, ll;
                att::attn_part<2, true>((const att::bf16_t*)(ws + WS_QAS) + ((size_t)bh * 16 + tq) * 64, (const att::bf16_t*)(ws + WS_KAS) + (size_t)bh * SPA * 64, (const att::bf16_t*)(ws + WS_VAST) + (size_t)bh * 64 * SPA, SPA,
                                        args.in[I_CAK] + (size_t)(bh >> 3) * 512 * 512 + (bh & 7) * 64, args.in[I_CAV] + (size_t)(bh >> 3) * 512 * 512 + (bh & 7) * 64, 16,
                                        wave, 8, 17, 528, 512 + tq, tbl + (bh & 7) * TBL_N, o, mm, ll, lane);
                att::combine8<2>(o, mm, ll, (LAS float*)L, pml, wave, lane);
                if (wave == 0) att::store_a(o, 1.0f, ya + ((size_t)32768 + (bh >> 3) * 16 + tq) * 512 + (bh & 7) * 64, h, r < 16);
            } else {
                const int bh = p - 128; float mm, ll;
                const int rr = wave >> 2, wq = wave & 3;
                att::f32x16 oo[4];
                att::attn_part<4, false>((const att::bf16_t*)(ws + WS_QBS) + ((size_t)(bh * 2 + rr) * 16 + tq) * 64, (const att::bf16_t*)(ws + WS_KBS) + (size_t)(bh * 2 + rr) * SPB * 64, (const att::bf16_t*)(ws + WS_VBST) + (size_t)bh * 128 * SPB, SPB,
                                         args.in[I_CBK] + (size_t)(bh >> 2) * 1024 * 512 + ((bh & 3) * 2 + rr) * 64, args.in[I_CBV] + (size_t)(bh >> 2) * 1024 * 512 + (bh & 3) * 128, 32,
                                         wq, 4, 33, 1040, 0, tbl, oo, mm, ll, lane);
                if (wq > 0) { LAS float* pw = (LAS float*)(L + (rr * 3 + wq - 1) * 16384) + lane; asm volatile("" : "+v"(pw));
#pragma unroll
                    for (int d = 0; d < 4; ++d)
#pragma unroll
                        for (int t = 0; t < 16; ++t) pw[(d * 16 + t) * 64] = oo[d][t]; }
                pml[wave * 128 + lane] = mm; pml[wave * 128 + 64 + lane] = ll;
                __syncthreads();
                LAS float* stash = (LAS float*)(L + 6 * 16384) + lane; asm volatile("" : "+v"(stash));
                if (wq == 0) {
                    const LAS float* pg = pml + rr * 512 + lane;
                    float M = pg[0], Ls = 0.f;
#pragma unroll
                    for (int i = 1; i < 4; ++i) M = fmaxf(M, pg[i * 128]);
#pragma unroll
                    for (int i = 0; i < 4; ++i) Ls += pg[i * 128 + 64] * __builtin_amdgcn_exp2f(pg[i * 128] - M);
                    const float inv = 1.0f / Ls, e0 = __builtin_amdgcn_exp2f(mm - M) * inv;
#pragma unroll
                    for (int d = 0; d < 4; ++d)
#pragma unroll
                        for (int t = 0; t < 16; ++t) oo[d][t] *= e0;
#pragma unroll 1
                    for (int i = 1; i < 4; ++i) {
                        const float ei = __builtin_amdgcn_exp2f(pg[i * 128] - M) * inv;
                        const LAS float* pi = (const LAS float*)(L + (rr * 3 + i - 1) * 16384) + lane; asm volatile("" : "+v"(pi));
#pragma unroll
                        for (int d = 0; d < 4; ++d)
#pragma unroll
                            for (int t = 0; t < 16; ++t) oo[d][t] += pi[(d * 16 + t) * 64] * ei;
                    }
                    if (rr == 1) {
#pragma unroll
                        for (int d = 0; d < 4; ++d)
#pragma unroll
                            for (int t = 0; t < 16; ++t) stash[(d * 16 + t) * 64] = oo[d][t];
                    }
                }
                __syncthreads();
                if (wave == 0) {
                    att::f32x16 o2[4];
#pragma unroll
                    for (int d = 0; d < 4; ++d)
#pragma unroll
                        for (int t = 0; t < 16; ++t) o2[d][t] = stash[(d * 16 + t) * 64];
                    att::finish_b(oo, o2, 1.0f, lam, subg, yb + ((size_t)32768 + (bh >> 2) * 16 + tq) * 512 + (bh & 3) * 128, h, r < 16);
                }
            }
        }
        __syncthreads();
    }
    xcd_barrier(xbar);
    {
        pg8::StaticOrder S; S.init(32768, 1024, G, bx);
        { pg8::Gemm g{(const pg8::bf16_t*)(ws + WS_YA), (const pg8::bf16_t*)(ws + WS_WPA), 32768, 1024, 512, 512};
          pg8::EpiP3<0> E{(const unsigned char*)(ws + WS_GATE), (pg8::bf16_t*)(ws + WS_MBUF)};
          pg8::gemm_phase<pg8::EpiP3<0>, pg8::StaticOrder, true, true>(L, g, S, E); }
        { pg8::Gemm g{(const pg8::bf16_t*)(ws + WS_YB), (const pg8::bf16_t*)(ws + WS_WPB), 32768, 1024, 512, 512};
          pg8::EpiP3<1> E{(const unsigned char*)(ws + WS_GATE), (pg8::bf16_t*)(ws + WS_MBUF)};
          pg8::gemm_phase<pg8::EpiP3<1>, pg8::StaticOrder, true, true>(L, g, S, E); }
        { const int pass = (bx >> 3) & 1, pn = (bx >> 1) & 3, ks = bx & 1;
          pg8::Gemm g{(const pg8::bf16_t*)(ws + (pass ? WS_YB : WS_YA)) + (size_t)32768 * 512 + ks * 256, (const pg8::bf16_t*)(ws + (pass ? WS_WPB : WS_WPA)) + ks * 256, 256, 1024, 512, 256}; pg8::OneUnit S1{bx < 16, pn};
          pg8::EpiP3Part E{(const unsigned char*)(ws + WS_GATE), pass * 1024, (float*)(ws + WS_PART + 8 * MiB) + (size_t)(pass * 2 + ks) * 256 * 1024};
          pg8::gemm_phase<pg8::EpiP3Part, pg8::OneUnit, true, true>(L, g, S1, E); }
    }
    xcd_barrier(xbar);

    {
        { pg8::Gemm g{(const pg8::bf16_t*)(ws + WS_MBUF), (const pg8::bf16_t*)(ws + WS_WOUT), 32768, 1024, 1024, 1024}; pg8::StaticOrder S; S.init(32768, 1024, G, bx);
          pg8::EpiP4 E{(const pg8::bf16_t*)(ws + WS_H), (const float*)(ws + WS_RINV), args.in[I_LN1], (pg8::bf16_t*)(ws + WS_X1G), (float*)(ws + WS_SSQ)};
          pg8::gemm_phase<pg8::EpiP4, pg8::StaticOrder, true, true>(L, g, S, E); }
        { const int pn = bx >> 2, ks = bx & 3;
          if (bx < 16) {
              const int t_ = wave * 64 + lane_id();
              for (int i = 0; i < 32; ++i) { const int e = i * 512 + t_, row = e >> 6, col = ks * 256 + 4 * (e & 63);
                  const float* pp = (const float*)(ws + WS_PART + 8 * MiB) + (size_t)row * 1024 + col;
                  f32x4 a = *(const f32x4*)pp;
#pragma unroll
                  for (int k = 1; k < 4; ++k) a += *(const f32x4*)(pp + (size_t)k * 256 * 1024);
                  *(unsigned long long*)((bf16*)(ws + WS_MBUF) + ((size_t)32768 + row) * 1024 + col) = (unsigned long long)pg8::pkbf(a[0], a[1]) | ((unsigned long long)pg8::pkbf(a[2], a[3]) << 32); }
              asm volatile("s_waitcnt vmcnt(0)" ::: "memory");
              __syncthreads();
          }
          pg8::Gemm g{(const pg8::bf16_t*)(ws + WS_MBUF) + (size_t)32768 * 1024 + ks * 256, (const pg8::bf16_t*)(ws + WS_WOUT) + ks * 256, 256, 1024, 1024, 256}; pg8::OneUnit S{bx < 16, pn};
          pg8::EpiP6Part E{(float*)(ws + WS_PART) + (size_t)ks * 256 * 1024};
          pg8::gemm_phase<pg8::EpiP6Part, pg8::OneUnit, true, true>(L, g, S, E); }
        xcd_barrier(xbar);
        if (gw < 256) {
            const int ln = lane_id(); const size_t row = (size_t)32768 + gw;
            const float rms = ((const float*)(ws + WS_RINV))[row]; float ss = 0.f;
#pragma unroll
            for (int j = 0; j < 4; ++j) { const int c = 256 * j + 4 * ln;
                f32x4 a = ((const f32x4*)((const float*)(ws + WS_PART) + (size_t)gw * 1024 + c))[0];
#pragma unroll
                for (int k = 1; k < 4; ++k) a += ((const f32x4*)((const float*)(ws + WS_PART) + (size_t)k * 256 * 1024 + (size_t)gw * 1024 + c))[0];
                const unsigned long long hq = *(const unsigned long long*)((const bf16*)(ws + WS_H) + row * 1024 + c);
                const f32x4 g1v = *(const f32x4*)(args.in[I_LN1] + c);
                const f32x4 xv = (f32x4){pg8::bflo((unsigned)hq), pg8::bfhi((unsigned)hq), pg8::bflo((unsigned)(hq >> 32)), pg8::bfhi((unsigned)(hq >> 32))} * rms / g1v;
                const f32x4 v = xv + a;
                ss += (v[0] * v[0] + v[1] * v[1]) + (v[2] * v[2] + v[3] * v[3]);
                *(unsigned long long*)((bf16*)(ws + WS_X1G) + row * 1024 + c) = (unsigned long long)pg8::pkbf(v[0], v[1]) | ((unsigned long long)pg8::pkbf(v[2], v[3]) << 32); }
            ss = wave_sum(ss);
            if (ln == 0) ((float*)(ws + WS_SSQ))[row] = ss;
        }
    }
    xcd_barrier(xbar);

    {
        pg8::Gemm g{(const pg8::bf16_t*)(ws + WS_X1G), (const pg8::bf16_t*)(ws + WS_WFF1), MROWS, 4096, 1024, 1024}; pg8::StaticOrder S; S.init(MROWS, 4096, G, bx);
        pg8::EpiP5 E{(const float*)(ws + WS_SSQ), (pg8::bf16_t*)(ws + WS_U)};
        pg8::gemm_phase<pg8::EpiP5, pg8::StaticOrder, true, true>(L, g, S, E);
    }
    xcd_barrier(xbar);

    {
        { pg8::Gemm g{(const pg8::bf16_t*)(ws + WS_U), (const pg8::bf16_t*)(ws + WS_WFF2), 32768, 1024, 4096, 4096}; pg8::StaticOrder S; S.init(32768, 1024, G, bx);
          pg8::EpiP6 E{(const pg8::bf16_t*)(ws + WS_X1G), out + O_Y};
          pg8::gemm_phase<pg8::EpiP6, pg8::StaticOrder, true, true>(L, g, S, E); }
        { const int pn = bx >> 4, ks = bx & 15;
          pg8::Gemm g{(const pg8::bf16_t*)(ws + WS_U) + (size_t)32768 * 4096 + ks * 256, (const pg8::bf16_t*)(ws + WS_WFF2) + ks * 256, 256, 1024, 4096, 256}; pg8::OneUnit S{bx < 64, pn};
          pg8::EpiP6Part E{(float*)(ws + WS_PART) + (size_t)ks * 256 * 1024};
          pg8::gemm_phase<pg8::EpiP6Part, pg8::OneUnit, true, true>(L, g, S, E); }
        xcd_barrier(xbar);
        { const int gt = gw * 64 + lane_id();
          if (gt < 65536) { const f32x4* pp = (const f32x4*)(ws + WS_PART) + gt; const unsigned long long xq = ((const unsigned long long*)((const bf16*)(ws + WS_X1G) + (size_t)32768 * 1024))[gt];
              f32x4 a = {pg8::bflo((unsigned)xq), pg8::bfhi((unsigned)xq), pg8::bflo((unsigned)(xq >> 32)), pg8::bfhi((unsigned)(xq >> 32))}; f32x4 v[16];
#pragma unroll
              for (int k = 0; k < 16; ++k) v[k] = pp[(size_t)k * 65536];
#pragma unroll
              for (int k = 0; k < 16; ++k) a += v[k];
              ((f32x4*)(out + O_Y + (size_t)32768 * 1024))[gt] = a; } }
    }
}

extern "C" void kernel_launch(void* const* d_in, const int* in_sizes, int n_in, void* d_out, int out_size, void* d_ws, size_t ws_size, hipStream_t stream) {
    static int grid = 0;
    if (grid == 0) {
        if (n_in != 26 || ws_size < WS_END) { fprintf(stderr, "kernel_launch: unexpected n_in %d / ws %zu\n", n_in, ws_size); grid = -1; return; }
        int dev = 0, cus = 0, per_cu = 0;
        hipGetDevice(&dev); hipDeviceGetAttribute(&cus, hipDeviceAttributeMultiprocessorCount, dev);
        if (hipFuncSetAttribute((const void*)mega_fwd, hipFuncAttributeMaxDynamicSharedMemorySize, LDS_BYTES) != hipSuccess) { fprintf(stderr, "kernel_launch: hipFuncSetAttribute failed\n"); grid = -1; return; }
        if (hipOccupancyMaxActiveBlocksPerMultiprocessor(&per_cu, (const void*)mega_fwd, NWAVES * 64, LDS_BYTES) != hipSuccess || per_cu < 1) { fprintf(stderr, "kernel_launch: occupancy query says %d\n", per_cu); per_cu = 1; }
        (void)hipGetLastError();
        grid = cus;
    }
    if (grid < 0) return;
    Args a{};
    for (int i = 0; i < 26; ++i) a.in[i] = (const float*)d_in[i];
    a.out = (float*)d_out; a.ws = (unsigned char*)d_ws;
    void* kargs[] = {&a};
    hipError_t e = hipLaunchCooperativeKernel((const void*)mega_fwd, dim3(grid), dim3(NWAVES * 64), kargs, LDS_BYTES, stream);
    if (e != hipSuccess) fprintf(stderr, "cooperative launch failed: %s (grid %d)\n", hipGetErrorString(e), grid);
}
```

```cpp
#include <hip/hip_runtime.h>
#include <hip/hip_cooperative_groups.h>
#include <cstdio>
#include <cstdint>
namespace cg = cooperative_groups;

constexpr int MROWS = 33024;
constexpr size_t MiB = 1u << 20;
constexpr size_t WS_WIN = 1 * MiB, WS_WPA = 11 * MiB, WS_WPB = 12 * MiB, WS_WOUT = 13 * MiB, WS_WFF1 = 15 * MiB, WS_WFF2 = 23 * MiB;
constexpr size_t WS_COS = 31 * MiB, WS_SIN = 31 * MiB + 256 * 1024, WS_SSQ = 31 * MiB + 512 * 1024;
constexpr size_t WS_H = 32 * MiB;
constexpr size_t WS_YA = 404 * MiB + 512 * 1024, WS_YB = 436 * MiB + 768 * 1024;
constexpr size_t WS_RINV = 31 * MiB + 768 * 1024;
constexpr size_t WS_QKV = 97 * MiB;
constexpr size_t WS_QAS = 289 * MiB, WS_QBS = 289 * MiB + 256 * 1024, WS_KAS = 289 * MiB + 512 * 1024, WS_VAST = 298 * MiB, WS_KBS = 306 * MiB + 512 * 1024, WS_VBST = 323 * MiB;
constexpr size_t WS_GATE = 340 * MiB;
constexpr size_t WS_X1G = 340 * MiB;
constexpr size_t WS_MBUF = 97 * MiB;
constexpr size_t WS_U = 32 * MiB;
constexpr size_t WS_BAR = 0;
constexpr size_t WS_PART = 469 * MiB;
constexpr size_t WS_END = 485 * MiB;
constexpr int SPA = 544, SOA = 512, SPB = 1056, SOB = 1024;
constexpr size_t O_Y = 0, O_AKP = 33816576, O_AVP = 38010880, O_BKP = 42205184, O_BVP = 58982400, O_AKS = 75759616, O_AVS = 75890688, O_BKS = 76021760, O_BVS = 76152832;
__device__ __forceinline__ int lane_id() { int l; asm volatile("v_mbcnt_lo_u32_b32 %0, -1, 0\n\tv_mbcnt_hi_u32_b32 %0, -1, %0" : "=v"(l)); return l; }
constexpr float EPSN = 1e-6f, LOG2E = 1.4426950408889634f, QSCALE = 0.125f * 1.4426950408889634f;

namespace pg8 {
#define PG8_LAS __attribute__((address_space(3)))
typedef unsigned short bf16_t;
typedef short bf16x8 __attribute__((ext_vector_type(8)));
typedef float f32x4 __attribute__((ext_vector_type(4)));
typedef unsigned u32x4 __attribute__((ext_vector_type(4)));
constexpr int BM = 256, BK = 64, HALF = 128, HTB = HALF * BK * 2  , STAGE_BYTES = 8 * HTB, NXCD = 8, WGM = 8;

__host__ __device__ __forceinline__ int lds_byte(int r, int c) { const int st = (r >> 4) * 2 + (c >> 5), rr = r & 15, cc = c & 31, ob = rr * 64 + cc * 2; return st * 1024 + (ob ^ (((ob >> 9) & 1) << 5)); }
__host__ __device__ __forceinline__ void stage_rc(int b, int& R, int& C) { const int st = b / 1024, sb = b % 1024, swz = sb ^ (((sb >> 9) & 1) << 5); R = (st >> 1) * 16 + swz / 64; C = (st & 1) * 32 + (swz % 64) / 2; }
__host__ __device__ __forceinline__ int perm32(int rho) { const int n = rho >> 4, i = rho & 15; return 8 * (i >> 2) + 4 * n + (i & 3); }

struct Unit { int pm, pn; };
struct Gemm { const bf16_t* A; const bf16_t* Bt; int M, N, K, KL; };

struct StaticOrder {
    int nM, nN, nwg, G, c;
    __host__ __device__ void init(int M, int N, int G_, int c_) { nM = M / BM; nN = N / BM; nwg = nM * nN; G = G_; c = c_; }
    __host__ __device__ bool next(int i, Unit& u) const {
        const long L = (long)i * G + c; if (L >= nwg) return false;
        int wgid = (int)L; { const int q = nwg / NXCD, r = nwg % NXCD, xcd = wgid % NXCD, off = wgid / NXCD; wgid = (xcd < r ? xcd * (q + 1) : r * (q + 1) + (xcd - r) * q) + off; }
        const int nig = WGM * nN, gid = wgid / nig, fm = gid * WGM, gsz = (nM - fm) < WGM ? (nM - fm) : WGM;
        u.pm = fm + ((wgid % nig) % gsz); u.pn = (wgid % nig) / gsz; return true;
    }
    __device__ __forceinline__ void a_ready(const Unit&) const {}
    __device__ __forceinline__ void done(const Unit&) const {}
};

__device__ __forceinline__ unsigned cvt_pk_bf16(float lo, float hi) { unsigned r; asm volatile("v_cvt_pk_bf16_f32 %0, %1, %2" : "=v"(r) : "v"(lo), "v"(hi)); return r; }
typedef float f32x2 __attribute__((ext_vector_type(2)));
typedef float f32x2e __attribute__((ext_vector_type(2))); typedef __bf16 bf16x2e __attribute__((ext_vector_type(2)));
__device__ __forceinline__ unsigned pkbf(float lo, float hi) { f32x2e v = {lo, hi}; bf16x2e b = __builtin_convertvector(v, bf16x2e); return __builtin_bit_cast(unsigned, b); }
__device__ __forceinline__ u32x4 pk8(const f32x4& a, const f32x4& b) { u32x4 w; w.x = pkbf(a[0], a[1]); w.y = pkbf(a[2], a[3]); w.z = pkbf(b[0], b[1]); w.w = pkbf(b[2], b[3]); return w; }
__device__ __forceinline__ float bflo(unsigned w) { return __uint_as_float(w << 16); }
__device__ __forceinline__ float bfhi(unsigned w) { return __uint_as_float(w & 0xffff0000u); }
typedef unsigned u32x2q __attribute__((ext_vector_type(2)));
__device__ __forceinline__ unsigned q8(const f32x4& g) {
    return (unsigned)(g[0] * 255.0f + 0.5f) | ((unsigned)(g[1] * 255.0f + 0.5f) << 8) | ((unsigned)(g[2] * 255.0f + 0.5f) << 16) | ((unsigned)(g[3] * 255.0f + 0.5f) << 24); }
__device__ __forceinline__ f32x4 dq8(unsigned w) { return (f32x4){(float)(w & 0xffu), (float)((w >> 8) & 0xffu), (float)((w >> 16) & 0xffu), (float)(w >> 24)} * (1.0f / 255.0f); }
__device__ __forceinline__ float sigm(float x) { return __builtin_amdgcn_rcpf(1.0f + __builtin_amdgcn_exp2f(-x * LOG2E)); }

struct EpiP1 {
    static constexpr bool PERM = true, AFTER_DRAIN = false;
    unsigned char* ws; float* out; const float *qn_a, *kn_a, *qn_b, *kn_b, *b_gate;
    __device__ __forceinline__ void operator()(const f32x4 (&acc)[2][2][4][2], const Unit& u, int wr, int wc, int fr, int fq) const {
        const int seg = u.pn >> 1;
        if (seg >= 6) {
            unsigned char* G = ws + WS_GATE;
            const int gc0 = u.pn * 256 - 3072 + wc * 64 + 8 * fq;
            f32x4 bv[2][2];
#pragma unroll
            for (int bj = 0; bj < 2; ++bj)
#pragma unroll
                for (int n = 0; n < 2; ++n) bv[bj][n] = *(const f32x4*)(b_gate + gc0 + 32 * bj + 4 * n);
#pragma unroll
            for (int ai = 0; ai < 2; ++ai)
#pragma unroll
                for (int m = 0; m < 4; ++m) {
                    int lrow = ai * 128 + wr * 64 + m * 16 + fr; asm volatile("" : "+v"(lrow));
                    const size_t row = (size_t)u.pm * 256 + lrow; unsigned char* rp = G + row * 2048 + gc0;
#pragma unroll
                    for (int bj = 0; bj < 2; ++bj) { f32x4 v0 = acc[ai][bj][m][0] + bv[bj][0], v1 = acc[ai][bj][m][1] + bv[bj][1];
#pragma unroll
                        for (int e = 0; e < 4; ++e) { v0[e] = sigm(v0[e]); v1[e] = sigm(v1[e]); }
                        u32x2q w; w.x = q8(v0); w.y = q8(v1); *(u32x2q*)(rp + 32 * bj) = w; }
                    asm volatile("" ::: "memory");
                }
            return;
        }
        const int h64 = (u.pn & 1) * 4 + wc;
        const bool samp = (u.pm == 128);
        const int kind = seg % 3;
        const bool isB = seg >= 3;
        const float* gain = kind == 2 ? nullptr : (isB ? (kind == 0 ? qn_b : kn_b) : (kind == 0 ? qn_a : kn_a));
        const bool rope = isB && kind != 2;
        bf16_t* base_p = (bf16_t*)(ws + WS_QKV + (size_t)seg * 32 * MiB);
        bf16_t* base_s = (bf16_t*)(ws + (seg == 0 ? WS_QAS : seg == 1 ? WS_KAS : seg == 2 ? WS_VAST : seg == 3 ? WS_QBS : seg == 4 ? WS_KBS : WS_VBST));
        const int spitch = kind == 0 ? 16 : (isB ? SPB : SPA), soff = kind == 0 ? 0 : (isB ? SOB : SOA);
        float* outp = out + (seg == 1 ? O_AKP : seg == 2 ? O_AVP : seg == 4 ? O_BKP : O_BVP);
        float* outs = out + (seg == 1 ? O_AKS : seg == 2 ? O_AVS : seg == 4 ? O_BKS : O_BVS);
        const int keep0 = isB ? 0 : 1536, orows = isB ? 2048 : 512;
        const float* cosT = (const float*)(ws + WS_COS); const float* sinT = (const float*)(ws + WS_SIN);
        f32x4 gq[2][2];
#pragma unroll
        for (int bj = 0; bj < 2; ++bj)
#pragma unroll
            for (int n = 0; n < 2; ++n) gq[bj][n] = gain ? *(const f32x4*)(gain + 32 * bj + 8 * fq + 4 * n) : (f32x4){1.f, 1.f, 1.f, 1.f};
#pragma unroll
        for (int ai = 0; ai < 2; ++ai)
#pragma unroll
            for (int m = 0; m < 4; ++m) {
                int lrow = ai * 128 + wr * 64 + m * 16 + fr; asm volatile("" : "+v"(lrow));
                int b, s, pos; if (!samp) { b = u.pm >> 3; s = (u.pm & 7) * 256 + lrow; pos = s; } else { b = lrow >> 4; s = lrow & 15; pos = 1024 + s; }
                f32x4 v[2][2];
#pragma unroll
                for (int bj = 0; bj < 2; ++bj)
#pragma unroll
                    for (int n = 0; n < 2; ++n) v[bj][n] = acc[ai][bj][m][n];
                if (gain) {
                    float ss = 0.f;
#pragma unroll
                    for (int bj = 0; bj < 2; ++bj)
#pragma unroll
                        for (int n = 0; n < 2; ++n) ss += (v[bj][n][0] * v[bj][n][0] + v[bj][n][1] * v[bj][n][1]) + (v[bj][n][2] * v[bj][n][2] + v[bj][n][3] * v[bj][n][3]);
                    ss += __shfl_xor(ss, 16); ss += __shfl_xor(ss, 32);
                    const float rstd = 1.0f / sqrtf(ss * (1.0f / 64.0f) + EPSN);
#pragma unroll
                    for (int bj = 0; bj < 2; ++bj)
#pragma unroll
                        for (int n = 0; n < 2; ++n) v[bj][n] = v[bj][n] * rstd * gq[bj][n];
                }
                if (rope) {
#pragma unroll
                    for (int n = 0; n < 2; ++n) { const f32x4 c = *(const f32x4*)(cosT + pos * 32 + 8 * fq + 4 * n), sn = *(const f32x4*)(sinT + pos * 32 + 8 * fq + 4 * n);
                        const f32x4 x1 = v[0][n], x2 = v[1][n]; v[0][n] = x1 * c - x2 * sn; v[1][n] = x2 * c + x1 * sn; }
                }
                if (kind != 0) {
                    float* op = nullptr;
                    if (!samp) { if (s >= keep0) op = outp + (((size_t)b * orows + (s - keep0)) * 8 + h64) * 64; } else op = outs + ((size_t)(b * 16 + s) * 8 + h64) * 64;
                    if (op) {
#pragma unroll
                        for (int bj = 0; bj < 2; ++bj)
#pragma unroll
                            for (int n = 0; n < 2; ++n) *(f32x4*)(op + 32 * bj + 8 * fq + 4 * n) = v[bj][n];
                    }
                }
                if (kind == 2) {
                    bf16_t* dp; size_t pitch;
                    if (!samp) { dp = base_p + ((size_t)(b * 8 + h64) * 64) * 2048 + s; pitch = 2048; } else { dp = base_s + ((size_t)(b * 8 + h64) * 64) * spitch + soff + s; pitch = spitch; }
#pragma unroll
                    for (int bj = 0; bj < 2; ++bj)
#pragma unroll
                        for (int n = 0; n < 2; ++n)
#pragma unroll
                            for (int e = 0; e < 4; ++e) dp[(size_t)(32 * bj + 8 * fq + 4 * n + e) * pitch] = (bf16_t)(pkbf(v[bj][n][e], 0.f) & 0xffffu);
                } else {
                    const float sc = kind == 0 ? QSCALE : 1.0f;
                    bf16_t* dp = !samp ? base_p + ((size_t)(b * 8 + h64) * 2048 + s) * 64 : base_s + ((size_t)(b * 8 + h64) * spitch + soff + s) * 64;
#pragma unroll
                    for (int bj = 0; bj < 2; ++bj) *(u32x4*)(dp + 32 * bj + 8 * fq) = pk8(v[bj][0] * sc, v[bj][1] * sc);
                }
                asm volatile("" ::: "memory");
            }
    }
};

template <int PASS> struct EpiP3 {
    static constexpr bool PERM = true, AFTER_DRAIN = false;
    const unsigned char* G; bf16_t* mb;
    __device__ __forceinline__ void operator()(const f32x4 (&acc)[2][2][4][2], const Unit& u, int wr, int wc, int fr, int fq) const {
#pragma unroll
        for (int ai = 0; ai < 2; ++ai) {
            u32x2q gw[4][2]; u32x4 pw[4][2];
#pragma unroll
            for (int m = 0; m < 4; ++m) { const size_t row = (size_t)u.pm * 256 + ai * 128 + wr * 64 + m * 16 + fr;
#pragma unroll
                for (int bj = 0; bj < 2; ++bj) { const int c0 = u.pn * 256 + wc * 64 + 32 * bj + 8 * fq;
                    gw[m][bj] = *(const u32x2q*)(G + row * 2048 + (PASS ? 1024 : 0) + c0);
                    if (PASS == 1) pw[m][bj] = *(const u32x4*)(mb + row * 1024 + c0); } }
            asm volatile("" ::: "memory");
#pragma unroll
            for (int m = 0; m < 4; ++m) { const size_t row = (size_t)u.pm * 256 + ai * 128 + wr * 64 + m * 16 + fr;
#pragma unroll
                for (int bj = 0; bj < 2; ++bj) { const int c0 = u.pn * 256 + wc * 64 + 32 * bj + 8 * fq; const u32x2q g = gw[m][bj];
                    const f32x4 g0 = dq8(g.x), g1 = dq8(g.y);
                    f32x4 v0 = acc[ai][bj][m][0] * g0, v1 = acc[ai][bj][m][1] * g1;
                    if (PASS == 1) { const u32x4 q = pw[m][bj];
                        v0 += (f32x4){bflo(q.x), bfhi(q.x), bflo(q.y), bfhi(q.y)}; v1 += (f32x4){bflo(q.z), bfhi(q.z), bflo(q.w), bfhi(q.w)}; }
                    *(u32x4*)(mb + row * 1024 + c0) = pk8(v0, v1); } }
            asm volatile("" ::: "memory");
        }
    }
};
struct EpiP4 {
    static constexpr bool PERM = true, AFTER_DRAIN = false;
    const bf16_t* H; const float* rinv; const float* g1; bf16_t* x1b; float* ssq;
    __device__ __forceinline__ void operator()(const f32x4 (&acc)[2][2][4][2], const Unit& u, int wr, int wc, int fr, int fq) const {
        f32x4 gi[2][2];
#pragma unroll
        for (int bj = 0; bj < 2; ++bj)
#pragma unroll
            for (int n = 0; n < 2; ++n) { const f32x4 g = *(const f32x4*)(g1 + u.pn * 256 + wc * 64 + 32 * bj + 8 * fq + 4 * n); gi[bj][n] = (f32x4){1.0f / g[0], 1.0f / g[1], 1.0f / g[2], 1.0f / g[3]}; }
#pragma unroll
        for (int ai = 0; ai < 2; ++ai) {
            u32x4 hv[4][2]; float rv[4];
#pragma unroll
            for (int m = 0; m < 4; ++m) { const size_t row = (size_t)u.pm * 256 + ai * 128 + wr * 64 + m * 16 + fr; rv[m] = rinv[row];
#pragma unroll
                for (int bj = 0; bj < 2; ++bj) hv[m][bj] = *(const u32x4*)(H + row * 1024 + u.pn * 256 + wc * 64 + 32 * bj + 8 * fq); }
            asm volatile("" ::: "memory");
#pragma unroll
            for (int m = 0; m < 4; ++m) { const size_t row = (size_t)u.pm * 256 + ai * 128 + wr * 64 + m * 16 + fr;
                float ss = 0.f;
#pragma unroll
                for (int bj = 0; bj < 2; ++bj) { const int c0 = u.pn * 256 + wc * 64 + 32 * bj + 8 * fq; const u32x4 q = hv[m][bj];
                    const f32x4 v0 = (f32x4){bflo(q.x), bfhi(q.x), bflo(q.y), bfhi(q.y)} * rv[m] * gi[bj][0] + acc[ai][bj][m][0], v1 = (f32x4){bflo(q.z), bfhi(q.z), bflo(q.w), bfhi(q.w)} * rv[m] * gi[bj][1] + acc[ai][bj][m][1];
                    ss += (v0[0] * v0[0] + v0[1] * v0[1]) + (v0[2] * v0[2] + v0[3] * v0[3]) + (v1[0] * v1[0] + v1[1] * v1[1]) + (v1[2] * v1[2] + v1[3] * v1[3]);
                    *(u32x4*)(x1b + row * 1024 + c0) = pk8(v0, v1); }
                ss += __shfl_xor(ss, 16); ss += __shfl_xor(ss, 32);
                if (fq == 0) atomicAdd(ssq + row, ss); }
            asm volatile("" ::: "memory");
        }
    }
};
struct EpiP5 {
    static constexpr bool PERM = true, AFTER_DRAIN = false;
    const float* ssq; bf16_t* U;
    __device__ __forceinline__ void operator()(const f32x4 (&acc)[2][2][4][2], const Unit& u, int wr, int wc, int fr, int fq) const {
#pragma unroll
        for (int ai = 0; ai < 2; ++ai)
#pragma unroll
            for (int m = 0; m < 4; ++m) {
                const size_t row = (size_t)u.pm * 256 + ai * 128 + wr * 64 + m * 16 + fr;
                const float rstd = 1.0f / sqrtf(ssq[row] * (1.0f / 1024.0f) + EPSN);
#pragma unroll
                for (int bj = 0; bj < 2; ++bj) { const int c0 = u.pn * 256 + wc * 64 + 32 * bj + 8 * fq;
                    f32x4 v0 = acc[ai][bj][m][0] * rstd, v1 = acc[ai][bj][m][1] * rstd;
#pragma unroll
                    for (int e = 0; e < 4; ++e) { const float a = fmaxf(v0[e], 0.f), b = fmaxf(v1[e], 0.f); v0[e] = a * a; v1[e] = b * b; }
                    *(u32x4*)(U + row * 4096 + c0) = pk8(v0, v1); }
            }
    }
};
struct EpiP6 {
    static constexpr bool PERM = true, AFTER_DRAIN = false;
    const bf16_t* x1b; float* y;
    __device__ __forceinline__ void operator()(const f32x4 (&acc)[2][2][4][2], const Unit& u, int wr, int wc, int fr, int fq) const {
#pragma unroll
        for (int ai = 0; ai < 2; ++ai) {
            u32x4 xv[4][2];
#pragma unroll
            for (int m = 0; m < 4; ++m) { const size_t row = (size_t)u.pm * 256 + ai * 128 + wr * 64 + m * 16 + fr;
#pragma unroll
                for (int bj = 0; bj < 2; ++bj) xv[m][bj] = *(const u32x4*)(x1b + row * 1024 + u.pn * 256 + wc * 64 + 32 * bj + 8 * fq); }
            asm volatile("" ::: "memory");
#pragma unroll
            for (int m = 0; m < 4; ++m) { const size_t row = (size_t)u.pm * 256 + ai * 128 + wr * 64 + m * 16 + fr;
#pragma unroll
                for (int bj = 0; bj < 2; ++bj) { float* pp = y + row * 1024 + u.pn * 256 + wc * 64 + 32 * bj + 8 * fq; const u32x4 q = xv[m][bj];
                    *(f32x4*)pp = (f32x4){bflo(q.x), bfhi(q.x), bflo(q.y), bfhi(q.y)} + acc[ai][bj][m][0]; *(f32x4*)(pp + 4) = (f32x4){bflo(q.z), bfhi(q.z), bflo(q.w), bfhi(q.w)} + acc[ai][bj][m][1]; } }
            asm volatile("" ::: "memory");
        }
    }
};
struct EpiP3Part {
    static constexpr bool PERM = true, AFTER_DRAIN = false;
    const unsigned char* G; int goff; float* part;
    __device__ __forceinline__ void operator()(const f32x4 (&acc)[2][2][4][2], const Unit& u, int wr, int wc, int fr, int fq) const {
#pragma unroll
        for (int ai = 0; ai < 2; ++ai)
#pragma unroll
            for (int m = 0; m < 4; ++m) {
                const size_t row = (size_t)ai * 128 + wr * 64 + m * 16 + fr;
#pragma unroll
                for (int bj = 0; bj < 2; ++bj) { const int c0 = u.pn * 256 + wc * 64 + 32 * bj + 8 * fq;
                    const u32x2q g = *(const u32x2q*)(G + ((size_t)32768 + row) * 2048 + goff + c0);
                    float* pp = part + row * 1024 + c0;
                    *(f32x4*)pp = acc[ai][bj][m][0] * dq8(g.x); *(f32x4*)(pp + 4) = acc[ai][bj][m][1] * dq8(g.y); }
            }
    }
};
struct OneUnit {
    int ok, pn;
    __device__ __forceinline__ bool next(int i, Unit& u) const { if (i != 0 || !ok) return false; u.pm = 0; u.pn = pn; return true; }
    __device__ __forceinline__ void a_ready(const Unit&) const {}
    __device__ __forceinline__ void done(const Unit&) const {}
};
struct EpiP6Part {
    static constexpr bool PERM = true, AFTER_DRAIN = false;
    float* part;
    __device__ __forceinline__ void operator()(const f32x4 (&acc)[2][2][4][2], const Unit& u, int wr, int wc, int fr, int fq) const {
#pragma unroll
        for (int ai = 0; ai < 2; ++ai)
#pragma unroll
            for (int m = 0; m < 4; ++m) {
                const size_t row = (size_t)ai * 128 + wr * 64 + m * 16 + fr;
#pragma unroll
                for (int bj = 0; bj < 2; ++bj) { float* pp = part + row * 1024 + u.pn * 256 + wc * 64 + 32 * bj + 8 * fq;
                    *(f32x4*)pp = acc[ai][bj][m][0]; *(f32x4*)(pp + 4) = acc[ai][bj][m][1]; }
            }
    }
};

template <class Epi, class Sched, bool ALIGN_EPI = false, bool SP2 = false>
__device__ __forceinline__ void gemm_phase(PG8_LAS unsigned char* lds, const Gemm g, const Sched& S, const Epi& E) {
    int tid_ = threadIdx.x; asm volatile("" : "+v"(tid_));
    const int tid = tid_, wid = __builtin_amdgcn_readfirstlane(tid >> 6), lane = tid & 63, wr = wid >> 2, wc = wid & 3, fr = lane & 15, fq = lane >> 4;
    const int K = g.K, nt = g.KL / BK;
    unsigned voffA[2], voffB[2];
#pragma unroll
    for (int i = 0; i < 2; ++i) { int R, C; stage_rc(tid * 16 + i * 8192, R, C); const int Rb = Epi::PERM ? ((R & ~31) + perm32(R & 31)) : R;
        voffA[i] = (unsigned)(R * K + C) * 2u; voffB[i] = (unsigned)(Rb * K + C) * 2u; }
    const size_t kstep = (size_t)(BK * 2);
    const size_t hstep = (size_t)HALF * K * 2;
    const size_t tstep = 2 * hstep;
    const unsigned ldsw = (unsigned)wid * 1024u;
    const int aoff = lds_byte(wr * 64 + fr, fq * 8), boff = lds_byte(wc * 32 + fr, fq * 8);
#define PG8_SA(b, h) (((b) * 2 + (h)) * HTB)
#define PG8_SB(b, h) ((4 + (b) * 2 + (h)) * HTB)
#define PG8_STAGE(bufoff, gbase, voff) do { _Pragma("unroll") for (int _i = 0; _i < 2; ++_i) \
        __builtin_amdgcn_global_load_lds((const unsigned*)((const char*)(gbase) + (voff)[_i]), (PG8_LAS unsigned*)(lds + (bufoff) + ldsw + _i * 8192), 16, 0, 0); } while (0)
#define PG8_LDA(dst, b, h) do { _Pragma("unroll") for (int m = 0; m < 4; ++m) _Pragma("unroll") for (int k = 0; k < 2; ++k) dst[m][k] = *(const PG8_LAS bf16x8*)(lds + PG8_SA(b, h) + aoff + m * 2048 + k * 1024); } while (0)
#define PG8_LDB(dst, b, h) do { _Pragma("unroll") for (int n = 0; n < 2; ++n) _Pragma("unroll") for (int k = 0; k < 2; ++k) dst[n][k] = *(const PG8_LAS bf16x8*)(lds + PG8_SB(b, h) + boff + n * 2048 + k * 1024); } while (0)
#define PG8_MMA(ai, bj, At, Bt) do { __builtin_amdgcn_s_setprio(1); _Pragma("unroll") for (int m = 0; m < 4; ++m) _Pragma("unroll") for (int n = 0; n < 2; ++n) _Pragma("unroll") for (int k = 0; k < 2; ++k) \
        acc[ai][bj][m][n] = __builtin_amdgcn_mfma_f32_16x16x32_bf16(Bt[n][k], At[m][k], acc[ai][bj][m][n], 0, 0, 0); __builtin_amdgcn_s_setprio(0); } while (0)
#define PG8_WAIT_V(n) asm volatile("s_waitcnt vmcnt(" #n ")" ::: "memory")
#define PG8_WAIT_L(n) asm volatile("s_waitcnt lgkmcnt(" #n ")" ::: "memory")
#define PG8_BAR __builtin_amdgcn_s_barrier()
#define PG8_SCHED __builtin_amdgcn_sched_barrier(0)
    Unit cur, nxt; int ui = 0;
    if (!S.next(0, cur)) return;
    f32x4 acc[2][2][4][2];
#pragma unroll
    for (int a = 0; a < 2; ++a)
#pragma unroll
        for (int b = 0; b < 2; ++b)
#pragma unroll
            for (int m = 0; m < 4; ++m)
#pragma unroll
                for (int n = 0; n < 2; ++n) acc[a][b][m][n] = (f32x4){0.f, 0.f, 0.f, 0.f};
    bf16x8 At[4][2], B0[2][2], B1[2][2];
    const char* cA = (const char*)g.A + (size_t)cur.pm * tstep; const char* cB = (const char*)g.Bt + (size_t)cur.pn * tstep;
    S.a_ready(cur);
    if constexpr (SP2) {
        PG8_STAGE(PG8_SB(0, 0), cB, voffB); PG8_STAGE(PG8_SB(0, 1), cB + hstep, voffB); PG8_STAGE(PG8_SA(0, 0), cA, voffA); PG8_STAGE(PG8_SA(0, 1), cA + hstep, voffA);
        if (wr == 1) PG8_BAR;
        PG8_WAIT_V(2); PG8_BAR;
        PG8_STAGE(PG8_SB(1, 0), cB + kstep, voffB); PG8_STAGE(PG8_SA(1, 0), cA + kstep, voffA); PG8_STAGE(PG8_SB(1, 1), cB + hstep + kstep, voffB);
        PG8_WAIT_V(6); PG8_BAR;
    } else {
        PG8_STAGE(PG8_SB(0, 0), cB, voffB); PG8_STAGE(PG8_SA(0, 0), cA, voffA); PG8_STAGE(PG8_SB(0, 1), cB + hstep, voffB); PG8_STAGE(PG8_SA(0, 1), cA + hstep, voffA);
        if (wr == 1) PG8_BAR;
        PG8_WAIT_V(4); PG8_BAR;
        PG8_STAGE(PG8_SB(1, 0), cB + kstep, voffB); PG8_STAGE(PG8_SA(1, 0), cA + kstep, voffA); PG8_STAGE(PG8_SB(1, 1), cB + hstep + kstep, voffB);
        PG8_WAIT_V(6); PG8_BAR;
    }
    for (;;) {
        const bool has_next = S.next(ui + 1, nxt);
        const char* nA = has_next ? (const char*)g.A + (size_t)nxt.pm * tstep : cA; const char* nB = has_next ? (const char*)g.Bt + (size_t)nxt.pn * tstep : cB;
        for (int t = 0; t < nt; t += 2) {
            const bool last = (t == nt - 2);
            const char* a1 = cA + (size_t)(t + 1) * kstep;
            const char* a2 = last ? nA : cA + (size_t)(t + 2) * kstep; const char* b2 = last ? nB : cB + (size_t)(t + 2) * kstep;
            const char* a3 = a2 + kstep; const char* b3 = b2 + kstep;
            if (last && has_next) S.a_ready(nxt);
            if constexpr (SP2) {
            PG8_LDB(B0, 0, 0); PG8_LDB(B1, 0, 1); PG8_SCHED; PG8_LDA(At, 0, 0); PG8_STAGE(PG8_SA(1, 1), a1 + hstep, voffA);
            PG8_WAIT_V(8); PG8_WAIT_L(0); PG8_BAR; PG8_MMA(0, 0, At, B0); PG8_MMA(0, 1, At, B1); PG8_BAR; PG8_SCHED;
            PG8_LDA(At, 0, 1); PG8_STAGE(PG8_SB(0, 0), b2, voffB); PG8_STAGE(PG8_SB(0, 1), b2 + hstep, voffB); PG8_STAGE(PG8_SA(0, 0), a2, voffA);
            PG8_WAIT_V(8); PG8_WAIT_L(0); PG8_BAR; PG8_MMA(1, 0, At, B0); PG8_MMA(1, 1, At, B1); PG8_BAR; PG8_SCHED;
            PG8_LDB(B0, 1, 0); PG8_LDB(B1, 1, 1); PG8_SCHED; PG8_LDA(At, 1, 0); PG8_STAGE(PG8_SA(0, 1), a2 + hstep, voffA);
            PG8_WAIT_V(8); PG8_WAIT_L(0); PG8_BAR; PG8_MMA(0, 0, At, B0); PG8_MMA(0, 1, At, B1); PG8_BAR; PG8_SCHED;
            PG8_LDA(At, 1, 1); PG8_STAGE(PG8_SB(1, 0), b3, voffB); PG8_STAGE(PG8_SB(1, 1), b3 + hstep, voffB); PG8_STAGE(PG8_SA(1, 0), a3, voffA);
            PG8_WAIT_V(8); PG8_WAIT_L(0); PG8_BAR; PG8_MMA(1, 0, At, B0); PG8_MMA(1, 1, At, B1); PG8_BAR; PG8_SCHED;
            } else {
            PG8_LDB(B0, 0, 0); PG8_SCHED; PG8_LDA(At, 0, 0); PG8_STAGE(PG8_SA(1, 1), a1 + hstep, voffA);
            PG8_WAIT_L(8); PG8_BAR; PG8_WAIT_L(0); PG8_MMA(0, 0, At, B0); PG8_BAR; PG8_SCHED;
            PG8_LDB(B1, 0, 1); PG8_STAGE(PG8_SB(0, 0), b2, voffB);
            PG8_BAR; PG8_WAIT_L(0); PG8_MMA(0, 1, At, B1); PG8_BAR;
            PG8_LDA(At, 0, 1); PG8_STAGE(PG8_SA(0, 0), a2, voffA);
            PG8_BAR; PG8_WAIT_L(0); PG8_MMA(1, 0, At, B0); PG8_BAR; PG8_SCHED;
            PG8_STAGE(PG8_SB(0, 1), b2 + hstep, voffB);
            PG8_WAIT_V(6); PG8_BAR; PG8_MMA(1, 1, At, B1); PG8_BAR;
            PG8_LDB(B0, 1, 0); PG8_SCHED; PG8_LDA(At, 1, 0); PG8_STAGE(PG8_SA(0, 1), a2 + hstep, voffA);
            PG8_WAIT_L(8); PG8_BAR; PG8_WAIT_L(0); PG8_MMA(0, 0, At, B0); PG8_BAR; PG8_SCHED;
            PG8_LDB(B1, 1, 1); PG8_STAGE(PG8_SB(1, 0), b3, voffB);
            PG8_BAR; PG8_WAIT_L(0); PG8_MMA(0, 1, At, B1); PG8_BAR;
            PG8_LDA(At, 1, 1); PG8_STAGE(PG8_SA(1, 0), a3, voffA);
            PG8_BAR; PG8_WAIT_L(0); PG8_MMA(1, 0, At, B0); PG8_BAR; PG8_SCHED;
            PG8_STAGE(PG8_SB(1, 1), b3 + hstep, voffB);
            PG8_WAIT_V(6); PG8_BAR; PG8_MMA(1, 1, At, B1); PG8_BAR;
            }
        }
        if constexpr (ALIGN_EPI) { if (wr == 0) PG8_BAR; }
        if constexpr (!Epi::AFTER_DRAIN) { E(acc, cur, wr, wc, fr, fq); S.done(cur); }
        if (!has_next) break;
#pragma unroll
        for (int a = 0; a < 2; ++a)
#pragma unroll
            for (int b = 0; b < 2; ++b)
#pragma unroll
                for (int m = 0; m < 4; ++m)
#pragma unroll
                    for (int n = 0; n < 2; ++n) acc[a][b][m][n] = (f32x4){0.f, 0.f, 0.f, 0.f};
        cur = nxt; cA = nA; cB = nB; ++ui;
        if constexpr (ALIGN_EPI) { if (wr == 1) PG8_BAR; }
    }
    PG8_WAIT_V(0);
    if constexpr (!ALIGN_EPI) { if (wr == 0) PG8_BAR; }
    PG8_BAR;
    if constexpr (Epi::AFTER_DRAIN) { E.fused(acc, cur, wr, wc, fr, fq, lds, wid, lane); S.done(cur); }
#undef PG8_SA
#undef PG8_SB
#undef PG8_STAGE
#undef PG8_LDA
#undef PG8_LDB
#undef PG8_MMA
#undef PG8_WAIT_V
#undef PG8_WAIT_L
#undef PG8_BAR
#undef PG8_SCHED
}
}
#define PG8_DONE 1
namespace att {
typedef unsigned short bf16_t;
typedef short bf16x8 __attribute__((ext_vector_type(8)));
typedef float f32x16 __attribute__((ext_vector_type(16)));
typedef float f32x4 __attribute__((ext_vector_type(4)));
typedef unsigned u32x4 __attribute__((ext_vector_type(4)));
typedef unsigned u32x2 __attribute__((ext_vector_type(2)));
#define ATT_LAS __attribute__((address_space(3)))
#define ATT_MFMA(a, b, c) __builtin_amdgcn_mfma_f32_32x32x16_bf16((a), (b), (c), 0, 0, 0)
using pg8::pkbf;
constexpr float RTHR = 8.0f;

template <int NDV>
__device__ __forceinline__ void softmax_step(f32x16& s, float& m, float& l, f32x16 (&o)[NDV], bf16x8 (&pf)[2]) {
    float mx = fmaxf(fmaxf(s[0], s[1]), fmaxf(s[2], s[3]));
#pragma unroll
    for (int t = 4; t < 16; t += 4) mx = fmaxf(mx, fmaxf(fmaxf(s[t], s[t + 1]), fmaxf(s[t + 2], s[t + 3])));
    mx = fmaxf(mx, __shfl_xor(mx, 32));
    const bool grow = mx > m + RTHR;
    if (__any(grow)) {
        const float mn = grow ? mx : m;
        const float alpha = __builtin_amdgcn_exp2f(m - mn);
        m = mn; l *= alpha;
#pragma unroll
        for (int d = 0; d < NDV; ++d)
#pragma unroll
            for (int t = 0; t < 16; ++t) o[d][t] *= alpha;
    }
    float ls = 0.f;
#pragma unroll
    for (int t = 0; t < 16; ++t) { s[t] = __builtin_amdgcn_exp2f(s[t] - m); ls += s[t]; }
    l += ls;
#pragma unroll
    for (int s2 = 0; s2 < 2; ++s2) { u32x4 w; w.x = pkbf(s[8 * s2], s[8 * s2 + 1]); w.y = pkbf(s[8 * s2 + 2], s[8 * s2 + 3]); w.z = pkbf(s[8 * s2 + 4], s[8 * s2 + 5]); w.w = pkbf(s[8 * s2 + 6], s[8 * s2 + 7]);
        pf[s2] = __builtin_bit_cast(bf16x8, w); }
}
__device__ __forceinline__ void softmax_step_nomax(f32x16& s, float& l, bf16x8 (&pf)[2]) {
    float ls0 = 0.f, ls1 = 0.f, ls2 = 0.f, ls3 = 0.f;
#pragma unroll
    for (int t = 0; t < 16; t += 4) { s[t] = __builtin_amdgcn_exp2f(s[t]); s[t + 1] = __builtin_amdgcn_exp2f(s[t + 1]); s[t + 2] = __builtin_amdgcn_exp2f(s[t + 2]); s[t + 3] = __builtin_amdgcn_exp2f(s[t + 3]);
        ls0 += s[t]; ls1 += s[t + 1]; ls2 += s[t + 2]; ls3 += s[t + 3]; }
    l += (ls0 + ls1) + (ls2 + ls3);
#pragma unroll
    for (int s2 = 0; s2 < 2; ++s2) { u32x4 w; w.x = pkbf(s[8 * s2], s[8 * s2 + 1]); w.y = pkbf(s[8 * s2 + 2], s[8 * s2 + 3]); w.z = pkbf(s[8 * s2 + 4], s[8 * s2 + 5]); w.w = pkbf(s[8 * s2 + 6], s[8 * s2 + 7]);
        pf[s2] = __builtin_bit_cast(bf16x8, w); }
}
__device__ __forceinline__ void store_a(const f32x16 (&o)[2], float inv, bf16_t* yrow, int h, bool valid) {
    if (!valid) return;
#pragma unroll
    for (int d = 0; d < 2; ++d)
#pragma unroll
        for (int g = 0; g < 4; ++g) { u32x2 w; w.x = pkbf(o[d][4 * g] * inv, o[d][4 * g + 1] * inv); w.y = pkbf(o[d][4 * g + 2] * inv, o[d][4 * g + 3] * inv); *(u32x2*)(yrow + 32 * d + 8 * g + 4 * h) = w; }
}
__device__ __forceinline__ void finish_b(f32x16 (&o1)[4], const f32x16 (&o2)[4], float i1, float i2l, const float* subg, bf16_t* yrow, int h, bool valid) {
    float ss = 0.f;
#pragma unroll
    for (int d = 0; d < 4; ++d)
#pragma unroll
        for (int t = 0; t < 16; ++t) { const float v = o1[d][t] * i1 - i2l * o2[d][t]; o1[d][t] = v; ss += v * v; }
    ss += __shfl_xor(ss, 32);
    const float sc = (1.0f / sqrtf(ss * (1.0f / 128.0f) + EPSN)) * 0.8f;
    if (!valid) return;
#pragma unroll
    for (int d = 0; d < 4; ++d)
#pragma unroll
        for (int g = 0; g < 4; ++g) { const int e0 = 32 * d + 8 * g + 4 * h; const f32x4 gg = *(const f32x4*)(subg + e0);
            u32x2 w; w.x = pkbf(o1[d][4 * g] * sc * gg[0], o1[d][4 * g + 1] * sc * gg[1]); w.y = pkbf(o1[d][4 * g + 2] * sc * gg[2], o1[d][4 * g + 3] * sc * gg[3]); *(u32x2*)(yrow + e0) = w;
            asm volatile("" ::: "memory"); }
}

template <int NR, int NDV, bool BIAS>
__device__ __forceinline__ void wg_attn(const bf16_t* __restrict__ Qg, const bf16_t* __restrict__ Kg, const bf16_t* __restrict__ VTg, int qb, ATT_LAS unsigned char* L, const ATT_LAS float* tbl,
                                        float lam, const float* subg, bf16_t* yout) {
    int tid = threadIdx.x; asm volatile("" : "+v"(tid));
    const int lane = tid & 63, w = __builtin_amdgcn_readfirstlane(tid >> 6), r = lane & 31, h = lane >> 5;
    const int pr = (r & 0x13) | ((r & 4) << 1) | ((r & 8) >> 1);
    const int swk = (pr >> 1) & 7, swv = (r >> 1) & 7;
    const int cw = qb * 4 + (w >> 1);
    const int tstart = BIAS ? (qb * 4 > 8 ? qb * 4 - 8 : 0) : 0;
    const int T = qb * 4 + 4 - tstart;
    const int srow = qb * 256 + w * 32 + r;
    constexpr int KT = 8192, VTB = NDV * 32 * 128, STAGE = NR * KT + VTB;
    bf16x8 qf[NR][4];
#pragma unroll
    for (int rr = 0; rr < NR; ++rr)
#pragma unroll
        for (int ds = 0; ds < 4; ++ds) qf[rr][ds] = *(const bf16x8*)(Qg + ((size_t)rr * 2048 + srow) * 64 + 16 * ds + 8 * h);
    f32x16 o[NR][NDV]; float m[NR], l[NR];
#pragma unroll
    for (int rr = 0; rr < NR; ++rr) { m[rr] = -INFINITY; l[rr] = 0.f;
#pragma unroll
        for (int d = 0; d < NDV; ++d)
#pragma unroll
            for (int t = 0; t < 16; ++t) o[rr][d][t] = 0.f; }
    const int rl = lane >> 3, slot = lane & 7;
#define ATT_DMA(t_, buf_) do { const int ct_ = tstart + (t_); ATT_LAS unsigned char* sb_ = L + (buf_) * STAGE; \
        _Pragma("unroll") for (int i_ = 0; i_ < NR; ++i_) { const int row_ = w * 8 + rl; const int c_ = slot ^ ((row_ >> 1) & 7); \
            __builtin_amdgcn_global_load_lds((const unsigned*)(Kg + ((size_t)i_ * 2048 + ct_ * 64 + row_) * 64 + c_ * 8), (ATT_LAS unsigned*)(sb_ + i_ * KT + w * 1024), 16, 0, 0); } \
        _Pragma("unroll") for (int i_ = 0; i_ < NDV / 2; ++i_) { const int d_ = (w + 8 * i_) * 8 + rl; const int c_ = slot ^ ((d_ >> 1) & 7); \
            __builtin_amdgcn_global_load_lds((const unsigned*)(VTg + (size_t)d_ * 2048 + ct_ * 64 + c_ * 8), (ATT_LAS unsigned*)(sb_ + NR * KT + (w + 8 * i_) * 1024), 16, 0, 0); } } while (0)
    constexpr int NST = (NR == 1) ? 4 : 3, LPG = NR + NDV / 2;
    static_assert(NST * STAGE <= 131072 && (NST - 2) * LPG == 4, "ring fits the phase scratch; the wait below is vmcnt(4)");
    asm volatile("s_waitcnt vmcnt(0)" ::: "memory");
#pragma unroll
    for (int i = 0; i < NST - 1; ++i) { const int ti = i < T ? i : T - 1; ATT_DMA(ti, i); }
    int cslot = 0, fslot = NST - 1;
    for (int t = 0; t < T; ++t) {
        asm volatile("s_waitcnt vmcnt(4)" ::: "memory");
        __builtin_amdgcn_s_barrier();
        asm volatile("" ::: "memory");
        { const int tn = t + NST - 1 < T ? t + NST - 1 : T - 1; ATT_DMA(tn, fslot); }
        const int ct = tstart + t;
        const bool vis = BIAS ? (ct >= cw - 8 && ct <= cw) : (ct <= cw);
        if (vis) {
            const ATT_LAS unsigned char* sb = L + cslot * STAGE;
            if constexpr (NR == 1) {
                f32x16 sv[2]; bf16x8 pf2[2][2];
#pragma unroll
                for (int kb2 = 0; kb2 < 2; ++kb2) {
#pragma unroll
                    for (int t2 = 0; t2 < 16; ++t2) sv[kb2][t2] = 0.f;
#pragma unroll
                    for (int ds = 0; ds < 4; ++ds) { const bf16x8 kf = *(const ATT_LAS bf16x8*)(sb + (kb2 * 32 + pr) * 128 + (((2 * ds + h) ^ swk) << 4)); sv[kb2] = ATT_MFMA(kf, qf[0][ds], sv[kb2]); }
                }
#pragma unroll
                for (int kb2 = 0; kb2 < 2; ++kb2) {
                    f32x16& s = sv[kb2];
                    if (BIAS) {
                        const int kbase = ct * 64 + kb2 * 32;
                        if (qb * 256 + w * 32 - (kbase + 31) >= 256) {
                            const float cb = tbl[319];
#pragma unroll
                            for (int t2 = 0; t2 < 16; ++t2) s[t2] += cb;
                        } else {
                            const ATT_LAS float* tb = tbl + (srow - kbase - 8 * h + 40);
#pragma unroll
                            for (int t2 = 0; t2 < 16; ++t2) s[t2] += tb[23 - (16 * (t2 >> 3) + (t2 & 7))];
                        }
                    }
                    softmax_step_nomax(s, l[0], pf2[kb2]);
                    __builtin_amdgcn_s_setprio(1);
#pragma unroll
                    for (int d = 0; d < NDV; ++d)
#pragma unroll
                        for (int s2 = 0; s2 < 2; ++s2) { const bf16x8 vf = *(const ATT_LAS bf16x8*)(sb + KT + (d * 32 + r) * 128 + (((4 * kb2 + 2 * s2 + h) ^ swv) << 4));
                            o[0][d] = ATT_MFMA(vf, pf2[kb2][s2], o[0][d]); }
                    __builtin_amdgcn_s_setprio(0);
                }
            } else
#pragma unroll 1
            for (int kb2 = 0; kb2 < 2; ++kb2) {
                bf16x8 pf[NR][2];
#pragma unroll
                for (int rr = 0; rr < NR; ++rr) {
                    f32x16 s;
#pragma unroll
                    for (int t2 = 0; t2 < 16; ++t2) s[t2] = 0.f;
#pragma unroll
                    for (int ds = 0; ds < 4; ++ds) { const bf16x8 kf = *(const ATT_LAS bf16x8*)(sb + rr * KT + (kb2 * 32 + pr) * 128 + (((2 * ds + h) ^ swk) << 4)); s = ATT_MFMA(kf, qf[rr][ds], s); }
                    if (BIAS) {
                        const int kbase = ct * 64 + kb2 * 32;
                        if (qb * 256 + w * 32 - (kbase + 31) >= 256) {
                            const float cb = tbl[319];
#pragma unroll
                            for (int t2 = 0; t2 < 16; ++t2) s[t2] += cb;
                        } else {
                            const ATT_LAS float* tb = tbl + (srow - kbase - 8 * h + 40);
#pragma unroll
                            for (int t2 = 0; t2 < 16; ++t2) s[t2] += tb[23 - (16 * (t2 >> 3) + (t2 & 7))];
                        }
                    }
                    if constexpr (NR == 2) softmax_step_nomax(s, l[rr], pf[rr]); else softmax_step<NDV>(s, m[rr], l[rr], o[rr], pf[rr]);
                }
                __builtin_amdgcn_s_setprio(1);
#pragma unroll
                for (int d = 0; d < NDV; ++d)
#pragma unroll
                    for (int s2 = 0; s2 < 2; ++s2) { const bf16x8 vf = *(const ATT_LAS bf16x8*)(sb + NR * KT + (d * 32 + r) * 128 + (((4 * kb2 + 2 * s2 + h) ^ swv) << 4));
#pragma unroll
                        for (int rr = 0; rr < NR; ++rr) o[rr][d] = ATT_MFMA(vf, pf[rr][s2], o[rr][d]); }
                __builtin_amdgcn_s_setprio(0);
            }
        }
        asm volatile("s_waitcnt lgkmcnt(0)" ::: "memory");
        cslot = (cslot == NST - 1) ? 0 : cslot + 1; fslot = (fslot == NST - 1) ? 0 : fslot + 1;
    }
    asm volatile("s_waitcnt vmcnt(0)" ::: "memory");
    __builtin_amdgcn_s_barrier();
    asm volatile("" ::: "memory");
#undef ATT_DMA
#pragma unroll
    for (int rr = 0; rr < NR; ++rr) { l[rr] += __shfl_xor(l[rr], 32); l[rr] = 1.0f / l[rr]; }
    if constexpr (NR == 1) store_a(o[0], l[0], yout + (size_t)srow * 512, h, true);
    else finish_b(o[0], o[1], l[0], lam * l[1], subg, yout + (size_t)srow * 512, h, true);
}

template <int NDV, bool BIAS>
__device__ __forceinline__ void attn_part(const bf16_t* __restrict__ q, const bf16_t* __restrict__ k, const bf16_t* __restrict__ vt, int vpitch, const float* __restrict__ kc, const float* __restrict__ vc, int ncb,
                                          int kb0, int kstep, int nkb, int nvalid, int dq, const ATT_LAS float* tbl, f32x16 (&o)[NDV], float& mout, float& lout, int lane_) {
    int lane = lane_; asm volatile("" : "+v"(lane));
    const int r = lane & 31, h = lane >> 5;
    const int pr = (r & 0x13) | ((r & 4) << 1) | ((r & 8) >> 1);
    bf16x8 qf[4];
#pragma unroll
    for (int ds = 0; ds < 4; ++ds) qf[ds] = *(const bf16x8*)(q + 16 * ds + 8 * h);
#pragma unroll
    for (int d = 0; d < NDV; ++d)
#pragma unroll
        for (int t = 0; t < 16; ++t) o[d][t] = 0.f;
    float mrun = -INFINITY, lrun = 0.f;
    const bf16_t* kp = k + pr * 64 + 8 * h;
    const bf16_t* vp = vt + (size_t)r * vpitch + 8 * h;
    const float* kcp = kc + (size_t)pr * 512 + 8 * h;
    const float* vcp = vc + (size_t)(8 * h) * 512 + r;
    for (int kb = kb0; kb < nkb; kb += kstep) {
        bf16x8 kf[4], vf[NDV][2];
        if (kb < ncb) {
            f32x4 kr[4][2];
#pragma unroll
            for (int ds = 0; ds < 4; ++ds) { kr[ds][0] = *(const f32x4*)(kcp + (size_t)kb * 32 * 512 + 16 * ds); kr[ds][1] = *(const f32x4*)(kcp + (size_t)kb * 32 * 512 + 16 * ds + 4); }
#pragma unroll
            for (int d = 0; d < NDV; ++d)
#pragma unroll
                for (int s2 = 0; s2 < 2; ++s2) { float vr[8];
#pragma unroll
                    for (int j = 0; j < 8; ++j) vr[j] = vcp[(size_t)(kb * 32 + 16 * s2 + j) * 512 + 32 * d];
                    u32x4 w; w.x = pkbf(vr[0], vr[1]); w.y = pkbf(vr[2], vr[3]); w.z = pkbf(vr[4], vr[5]); w.w = pkbf(vr[6], vr[7]); vf[d][s2] = __builtin_bit_cast(bf16x8, w); }
#pragma unroll
            for (int ds = 0; ds < 4; ++ds) { u32x4 w; w.x = pkbf(kr[ds][0][0], kr[ds][0][1]); w.y = pkbf(kr[ds][0][2], kr[ds][0][3]); w.z = pkbf(kr[ds][1][0], kr[ds][1][1]); w.w = pkbf(kr[ds][1][2], kr[ds][1][3]); kf[ds] = __builtin_bit_cast(bf16x8, w); }
        } else {
#pragma unroll
            for (int ds = 0; ds < 4; ++ds) kf[ds] = *(const bf16x8*)(kp + (size_t)kb * 2048 + 16 * ds);
#pragma unroll
            for (int d = 0; d < NDV; ++d)
#pragma unroll
                for (int s2 = 0; s2 < 2; ++s2) vf[d][s2] = *(const bf16x8*)(vp + (size_t)d * 32 * vpitch + kb * 32 + 16 * s2);
        }
        f32x16 s;
#pragma unroll
        for (int t = 0; t < 16; ++t) s[t] = 0.f;
#pragma unroll
        for (int ds = 0; ds < 4; ++ds) s = ATT_MFMA(kf[ds], qf[ds], s);
        const int key0 = kb * 32 + 8 * h;
        if (BIAS) {
#pragma unroll
            for (int t = 0; t < 16; ++t) s[t] += tbl[dq - (key0 + 16 * (t >> 3) + (t & 7)) + 63];
        }
        if ((kb + 1) * 32 > nvalid) {
#pragma unroll
            for (int t = 0; t < 16; ++t) if (key0 + 16 * (t >> 3) + (t & 7) >= nvalid) s[t] = -INFINITY;
        }
        bf16x8 pf[2];
        softmax_step<NDV>(s, mrun, lrun, o, pf);
#pragma unroll
        for (int d = 0; d < NDV; ++d)
#pragma unroll
            for (int s2 = 0; s2 < 2; ++s2) o[d] = ATT_MFMA(vf[d][s2], pf[s2], o[d]);
    }
    lrun += __shfl_xor(lrun, 32);
    mout = mrun; lout = lrun;
}
template <int NDV>
__device__ __forceinline__ void combine8(f32x16 (&o)[NDV], float m, float l, ATT_LAS float* po  , ATT_LAS float* pml  , int w, int lane) {
    if (w > 0) {
        ATT_LAS float* pw = po + (w - 1) * NDV * 16 * 64 + lane; asm volatile("" : "+v"(pw));
#pragma unroll
        for (int d = 0; d < NDV; ++d)
#pragma unroll
            for (int t = 0; t < 16; ++t) pw[(d * 16 + t) * 64] = o[d][t];
    }
    pml[w * 128 + lane] = m; pml[w * 128 + 64 + lane] = l;
    __syncthreads();
    if (w == 0) {
        float M = pml[lane], Ls = 0.f;
#pragma unroll
        for (int i = 1; i < 8; ++i) M = fmaxf(M, pml[i * 128 + lane]);
#pragma unroll
        for (int i = 0; i < 8; ++i) Ls += pml[i * 128 + 64 + lane] * __builtin_amdgcn_exp2f(pml[i * 128 + lane] - M);
        const float inv = 1.0f / Ls;
        const float e0 = __builtin_amdgcn_exp2f(m - M) * inv;
#pragma unroll
        for (int d = 0; d < NDV; ++d)
#pragma unroll
            for (int t = 0; t < 16; ++t) o[d][t] *= e0;
#pragma unroll 1
        for (int i = 1; i < 8; ++i) {
            const float ei = __builtin_amdgcn_exp2f(pml[i * 128 + lane] - M) * inv;
            const ATT_LAS float* pi = po + (i - 1) * NDV * 16 * 64 + lane; asm volatile("" : "+v"(pi));
#pragma unroll
            for (int d = 0; d < NDV; ++d)
#pragma unroll
                for (int t = 0; t < 16; ++t) o[d][t] += pi[(d * 16 + t) * 64] * ei;
        }
    }
    __syncthreads();
}
}

#define LAS __attribute__((address_space(3)))
typedef unsigned short bf16;
typedef unsigned v4u __attribute__((ext_vector_type(4)));
typedef float f32x4 __attribute__((ext_vector_type(4)));
constexpr int NWAVES = 8;
constexpr int RING_BYTES = 131072, TBL_OFF = RING_BYTES, TBL_N = 640, PML_OFF = TBL_OFF + 8 * TBL_N * 4, BST_OFF = PML_OFF + 4096, LDS_BYTES = 157696;

struct Args { const float* in[26]; float* out; unsigned char* ws; };
enum { I_XP = 0, I_XS, I_CAK, I_CAV, I_CBK, I_CBV, I_LN1, I_WIN, I_QNA, I_KNA, I_REL, I_QNB, I_KNB, I_LQ1, I_LK1, I_LQ2, I_LK2, I_SUBG, I_WG, I_BG, I_WPA, I_WPB, I_WOUT, I_LN2, I_WFF1, I_WFF2 };

__device__ __forceinline__ float wave_sum(float v) {
#pragma unroll
    for (int o = 1; o < 64; o <<= 1) v += __shfl_xor(v, o);
    return v;
}
__device__ __forceinline__ void tr_item(const float* W, int ldw, bf16* WT, int ldt, int k0, int n0, int rowbase, LAS float* scr, int lane, const float* kscale = nullptr) {
    float tv[32];
#pragma unroll
    for (int i = 0; i < 32; ++i) { const int kk = 2 * i + (lane >> 5); tv[i] = W[(size_t)(k0 + kk) * ldw + n0 + (lane & 31)]; }
#pragma unroll
    for (int i = 0; i < 32; ++i) { const int kk = 2 * i + (lane >> 5); scr[kk * 33 + (lane & 31)] = kscale ? tv[i] * kscale[k0 + kk] : tv[i]; }
    asm volatile("s_waitcnt lgkmcnt(0)" ::: "memory");
    const int c = lane & 7;
#pragma unroll
    for (int j = 0; j < 4; ++j) { const int n = (lane >> 3) + 8 * j; const LAS float* s = scr + (8 * c) * 33 + n;
        v4u o; o.x = pg8::pkbf(s[0 * 33], s[1 * 33]); o.y = pg8::pkbf(s[2 * 33], s[3 * 33]); o.z = pg8::pkbf(s[4 * 33], s[5 * 33]); o.w = pg8::pkbf(s[6 * 33], s[7 * 33]);
        *(v4u*)(WT + (size_t)(rowbase + n) * ldt + k0 + 8 * c) = o; }
    asm volatile("s_waitcnt lgkmcnt(0)" ::: "memory");
}
__device__ __forceinline__ int permrow(int c) { return (c & ~255) + ((c >> 5) & 1) * 128 + ((c >> 6) & 3) * 32; }

#define XB_TMO      128
#define XB_XCNT(j)  (256  + 64 * (j))
#define XB_XSUB(j)  (1280 + 64 * (j))
#define XB_XGEN(j)  (2304 + 64 * (j))
#define XB_TOP      3328
#define XB_TOPGEN   3392
#define XCD_BAR_WORDS 3456
#define XB_SPIN_CAP (1u << 18)

__device__ __forceinline__ unsigned xb_ld(unsigned* p)              { return __hip_atomic_load(p, __ATOMIC_RELAXED, __HIP_MEMORY_SCOPE_AGENT); }
__device__ __forceinline__ unsigned xb_add(unsigned* p, unsigned v) { return __hip_atomic_fetch_add(p, v, __ATOMIC_RELAXED, __HIP_MEMORY_SCOPE_AGENT); }
__device__ __forceinline__ unsigned xb_xcc_id() { return (unsigned)__builtin_amdgcn_s_getreg((3 << 11) | 20) & 0xFu; }
#define XB_SPIN(cond, bar) do { unsigned _sp = 0; while (cond) { __builtin_amdgcn_s_sleep(1); \
    if ((++_sp & 255u) == 0u) { if (xb_ld(&(bar)[XB_TMO])) break; if (_sp > XB_SPIN_CAP) { atomicAdd(&(bar)[XB_TMO], 1u); break; } } } } while (0)

struct XcdBarrier {
    unsigned* bar; unsigned x;
    volatile LAS unsigned* st;
};

__device__ __forceinline__ XcdBarrier xcd_barrier_post(unsigned* bar, volatile LAS unsigned* st) {
    XcdBarrier b; b.bar = bar; b.x = xb_xcc_id(); b.st = st;
    if (threadIdx.x == 0) (void)xb_add(&bar[XB_XCNT(b.x)], 1u);
    return b;
}
__device__ __forceinline__ void xcd_barrier_complete(unsigned* bar, unsigned x, unsigned& nloc, unsigned& nx) {
    const unsigned G = gridDim.x * gridDim.y * gridDim.z;
    unsigned sum, cnt, mine, sp = 0u;
    for (;;) {
        sum = 0u; cnt = 0u; mine = 0u;
#pragma unroll
        for (unsigned j = 0; j < 16; ++j) { const unsigned c = xb_ld(&bar[XB_XCNT(j)]); sum += c; cnt += (c > 0u) ? 1u : 0u; mine = (j == x) ? c : mine; }
        if (sum == G) break;
        __builtin_amdgcn_s_sleep(1);
        if ((++sp & 255u) == 0u) { if (xb_ld(&bar[XB_TMO])) break; if (sp > XB_SPIN_CAP) { atomicAdd(&bar[XB_TMO], 1u); break; } }
    }
    nloc = mine > 0u ? mine : 1u; nx = cnt > 0u ? cnt : 1u;
}

__device__ __forceinline__ void xcd_barrier(const XcdBarrier& b) {
    asm volatile("s_waitcnt vmcnt(0)" ::: "memory");
    __syncthreads();
    if (threadIdx.x == 0) {
        unsigned* bar = b.bar;
        __builtin_amdgcn_s_waitcnt(0);
        unsigned nloc = b.st[0], nx = b.st[1];
        if (nloc == 0u) { xcd_barrier_complete(bar, b.x, nloc, nx); b.st[0] = nloc; b.st[1] = nx; }
        const unsigned old = xb_add(&bar[XB_XSUB(b.x)], 1u);
        const unsigned gen = old / nloc;
        if (old + 1u == (gen + 1u) * nloc) {
            __builtin_amdgcn_fence(__ATOMIC_RELEASE, "agent");
            asm volatile("s_waitcnt vmcnt(0)" ::: "memory");
            const unsigned og = xb_add(&bar[XB_TOP], 1u);
            const unsigned tg = og / nx;
            if (og + 1u == (tg + 1u) * nx) xb_add(&bar[XB_TOPGEN], 1u);
            else XB_SPIN(xb_ld(&bar[XB_TOPGEN]) == tg, bar);
            __builtin_amdgcn_fence(__ATOMIC_ACQUIRE, "agent");
            xb_add(&bar[XB_XGEN(b.x)], 1u);
            asm volatile("s_waitcnt vmcnt(0)" ::: "memory");
        } else {
            XB_SPIN(xb_ld(&bar[XB_XGEN(b.x)]) == gen, bar);
            __builtin_amdgcn_fence(__ATOMIC_ACQUIRE, "agent");
            asm volatile("s_waitcnt vmcnt(0)" ::: "memory");
        }
    }
    __syncthreads();
}

__global__ void __launch_bounds__(NWAVES * 64, 2) mega_fwd(Args args) {
    extern __shared__ __attribute__((aligned(16))) unsigned char lds[];
    cg::grid_group grid = cg::this_grid();
    LAS unsigned char* L = (LAS unsigned char*)lds;
    const int tid = threadIdx.x, lane = tid & 63, wave = __builtin_amdgcn_readfirstlane(tid >> 6);
    const int G = gridDim.x, bx = blockIdx.x;
    const int vcu = (G % 8 == 0) ? (bx % 8) * (G / 8) + bx / 8 : bx;
    const int gw = vcu * NWAVES + wave, NGW = G * NWAVES;
    unsigned char* ws = args.ws; float* out = args.out;
    volatile LAS unsigned* bst = (volatile LAS unsigned*)(L + BST_OFF);
    if (threadIdx.x < 2) bst[threadIdx.x] = 0u;
    for (int i = gw * 64 + lane; i < XCD_BAR_WORDS + 64; i += NGW * 64) ((unsigned*)(ws + WS_BAR))[i] = 0u;
    __syncthreads();
    grid.sync();
    const XcdBarrier xbar = xcd_barrier_post((unsigned*)(ws + WS_BAR), bst);

    {
        LAS float* scr = (LAS float*)(L + wave * 16384);
        constexpr int N_WIN = 16 * 96, N_WG = 16 * 64;
        for (int it = gw; it < N_WIN + N_WG; it += NGW) {
            int r = it;
            if (r < N_WIN) { const int kb = r / 96, nb = r % 96; tr_item(args.in[I_WIN], 3072, (bf16*)(ws + WS_WIN), 1024, kb * 64, nb * 32, permrow(nb * 32), scr, lane); continue; } r -= N_WIN;
            { const int kb = r / 64, nb = r % 64; tr_item(args.in[I_WG], 2048, (bf16*)(ws + WS_WIN), 1024, kb * 64, nb * 32, permrow(3072 + nb * 32), scr, lane); }
        }
        {
            const f32x4* gp = (const f32x4*)args.in[I_LN1] + lane; f32x4 gv[4];
#pragma unroll
            for (int j = 0; j < 4; ++j) gv[j] = gp[64 * j];
            for (int row0 = gw; row0 < MROWS; row0 += 4 * NGW) {
                f32x4 v[4][4];
#pragma unroll
                for (int q = 0; q < 4; ++q) { const int row = row0 + q * NGW;
                    if (row < MROWS) { const float* xr = row < 32768 ? args.in[I_XP] + (size_t)row * 1024 : args.in[I_XS] + (size_t)(row - 32768) * 1024;
                        const f32x4* xp4 = (const f32x4*)xr + lane;
#pragma unroll
                        for (int j = 0; j < 4; ++j) v[q][j] = xp4[64 * j]; } }
#pragma unroll
                for (int q = 0; q < 4; ++q) { const int row = row0 + q * NGW;
                    if (row < MROWS) { float s = 0.f;
#pragma unroll
                        for (int j = 0; j < 4; ++j) s += (v[q][j][0] * v[q][j][0] + v[q][j][1] * v[q][j][1]) + (v[q][j][2] * v[q][j][2] + v[q][j][3] * v[q][j][3]);
                        const float rms = sqrtf(wave_sum(s) * (1.0f / 1024.0f) + EPSN); const float rstd = 1.0f / rms;
                        if (lane == 0) ((float*)(ws + WS_RINV))[row] = rms;
                        unsigned long long* o8 = (unsigned long long*)((bf16*)(ws + WS_H) + (size_t)row * 1024) + lane;
#pragma unroll
                        for (int j = 0; j < 4; ++j) { const f32x4 y = v[q][j] * rstd * gv[j]; o8[64 * j] = (unsigned long long)pg8::pkbf(y[0], y[1]) | ((unsigned long long)pg8::pkbf(y[2], y[3]) << 32); } } }
            }
        }
        {
            const int gt = gw * 64 + lane, NT = NGW * 64;
            for (int i = gt; i < 8192 * 2; i += NT) { const int row = i >> 1, hf = i & 1;
                *(v4u*)((bf16*)(ws + WS_VAST) + (size_t)row * SPA + 528 + 8 * hf) = (v4u){0u, 0u, 0u, 0u};
                *(v4u*)((bf16*)(ws + WS_VBST) + (size_t)row * SPB + 1040 + 8 * hf) = (v4u){0u, 0u, 0u, 0u}; }
            for (int i = gt; i < 2048 * 32; i += NT) { const int pos = i >> 5, d = i & 31;
                const float inv_freq = exp2f(-(float)d * (13.287712379549449f / 32.0f));
                const float ang = (float)pos * inv_freq;
                const double rev = (double)ang * 0.15915494309189535; const float fr = (float)(rev - __builtin_rint(rev));
                ((float*)(ws + WS_COS))[i] = __builtin_amdgcn_cosf(fr); ((float*)(ws + WS_SIN))[i] = __builtin_amdgcn_sinf(fr); }
            for (int i = gt; i < MROWS; i += NT) ((float*)(ws + WS_SSQ))[i] = 0.f;
        }
    }
    xcd_barrier(xbar);

    {
        pg8::Gemm g{(const pg8::bf16_t*)(ws + WS_H), (const pg8::bf16_t*)(ws + WS_WIN), MROWS, 5120, 1024, 1024}; pg8::StaticOrder S; S.init(MROWS, 5120, G, bx);
        pg8::EpiP1 E{ws, out, args.in[I_QNA], args.in[I_KNA], args.in[I_QNB], args.in[I_KNB], args.in[I_BG]};
        pg8::gemm_phase<pg8::EpiP1, pg8::StaticOrder, true, true>(L, g, S, E);
        {
            const int lane2 = lane_id();
            LAS float* scr = (LAS float*)(L + wave * 16384);
            constexpr int N_PA = 8 * 32, N_PB = 8 * 32, N_WO = 16 * 32, N_F1 = 16 * 128, N_F2 = 64 * 32;
            constexpr int NDEF = N_PA + N_PB + N_WO + N_F1 + N_F2;
            const int rem = (129 * 20) % G, nidle = (G - rem) * NWAVES;
            if (bx >= rem)
            for (int it = (bx - rem) * NWAVES + wave; it < NDEF; it += nidle) {
                int r = it;
                if (r < N_PA) { const int kb = r / 32, nb = r % 32; tr_item(args.in[I_WPA], 1024, (bf16*)(ws + WS_WPA), 512, kb * 64, nb * 32, permrow(nb * 32), scr, lane2); continue; } r -= N_PA;
                if (r < N_PB) { const int kb = r / 32, nb = r % 32; tr_item(args.in[I_WPB], 1024, (bf16*)(ws + WS_WPB), 512, kb * 64, nb * 32, permrow(nb * 32), scr, lane2); continue; } r -= N_PB;
                if (r < N_WO) { const int kb = r / 32, nb = r % 32; tr_item(args.in[I_WOUT], 1024, (bf16*)(ws + WS_WOUT), 1024, kb * 64, nb * 32, permrow(nb * 32), scr, lane2); continue; } r -= N_WO;
                if (r < N_F1) { const int kb = r / 128, nb = r % 128; tr_item(args.in[I_WFF1], 4096, (bf16*)(ws + WS_WFF1), 1024, kb * 64, nb * 32, permrow(nb * 32), scr, lane2, args.in[I_LN2]); continue; } r -= N_F1;
                if (r < N_F2) { const int kb = r / 32, nb = r % 32; tr_item(args.in[I_WFF2], 1024, (bf16*)(ws + WS_WFF2), 4096, kb * 64, nb * 32, permrow(nb * 32), scr, lane2); }
            }
        }
    }
    xcd_barrier(xbar);

    {
        int tid2 = threadIdx.x; asm volatile("" : "+v"(tid2));
        const int tid = tid2, lane = tid & 63, wave = __builtin_amdgcn_readfirstlane(tid >> 6);
        LAS float* tbl = (LAS float*)(L + TBL_OFF);
        LAS float* pml = (LAS float*)(L + PML_OFF);
        for (int i = tid; i < 8 * TBL_N; i += NWAVES * 64) { const int hh = i / TBL_N, j = i % TBL_N; tbl[i] = args.in[I_REL][hh * 320 + (j < 319 ? j : 319)] * LOG2E; }
        __syncthreads();
        const float d1 = wave_sum(args.in[I_LQ1][lane] * args.in[I_LK1][lane]), d2 = wave_sum(args.in[I_LQ2][lane] * args.in[I_LK2][lane]);
        const float lam = __expf(d1) - __expf(d2) + 0.2f;
        const int r = lane & 31, h = lane >> 5;
        const float* subg = args.in[I_SUBG];
        const att::bf16_t* Qa = (const att::bf16_t*)(ws + WS_QKV), *Ka = Qa + 16 * MiB, *VaT = Qa + 32 * MiB, *Qb = Qa + 48 * MiB, *Kb = Qa + 64 * MiB, *VbT = Qa + 80 * MiB;
        att::bf16_t* ya = (att::bf16_t*)(ws + WS_YA); att::bf16_t* yb = (att::bf16_t*)(ws + WS_YB);
        for (int p = vcu; p < 256; p += G) {
            const int bh = p >> 2, i = p & 3;
            for (int j = 0; j < 2; ++j) {
                const int qb = j ? 7 - i : i;
                att::wg_attn<2, 4, false>(Qb + (size_t)bh * 2 * 2048 * 64, Kb + (size_t)bh * 2 * 2048 * 64, VbT + (size_t)bh * 128 * 2048, qb, L, tbl, lam, subg,
                                          yb + (size_t)(bh >> 2) * 2048 * 512 + (bh & 3) * 128);
            }
        }
        const bool bal = (G == 256);
        for (int p = vcu; p < 256; p += G) {
            const int nj = (bal && p >= 128 && p < 192) ? 3 : ((bal && p >= 192) ? 5 : 4);
            for (int j = 0; j < nj; ++j) {
                const int ps = j < 4 ? p : p - 64, jj = j < 4 ? j : 3;
                const int bh = ps >> 1, qb = (ps & 1) + 2 * jj;
                att::wg_attn<1, 2, true>(Qa + (size_t)bh * 2048 * 64, Ka + (size_t)bh * 2048 * 64, VaT + (size_t)bh * 64 * 2048, qb, L, tbl + (bh & 7) * TBL_N, 0.f, subg,
                                         ya + (size_t)(bh >> 3) * 2048 * 512 + (bh & 7) * 64);
            }
        }
        for (int p = vcu; p < 192; p += G) {
            const int tq = r & 15;
            if (p < 128) {
                const int bh = p; att::f32x16 o[2]; float mm, ll;
                att::attn_part<2, true>((const att::bf16_t*)(ws + WS_QAS) + ((size_t)bh * 16 + tq) * 64, (const att::bf16_t*)(ws + WS_KAS) + (size_t)bh * SPA * 64, (const att::bf16_t*)(ws + WS_VAST) + (size_t)bh * 64 * SPA, SPA,
                                        args.in[I_CAK] + (size_t)(bh >> 3) * 512 * 512 + (bh & 7) * 64, args.in[I_CAV] + (size_t)(bh >> 3) * 512 * 512 + (bh & 7) * 64, 16,
                                        wave, 8, 17, 528, 512 + tq, tbl + (bh & 7) * TBL_N, o, mm, ll, lane);
                att::combine8<2>(o, mm, ll, (LAS float*)L, pml, wave, lane);
                if (wave == 0) att::store_a(o, 1.0f, ya + ((size_t)32768 + (bh >> 3) * 16 + tq) * 512 + (bh & 7) * 64, h, r < 16);
            } else {
                const int bh = p - 128; float mm, ll;
                const int rr = wave >> 2, wq = wave & 3;
                att::f32x16 oo[4];
                att::attn_part<4, false>((const att::bf16_t*)(ws + WS_QBS) + ((size_t)(bh * 2 + rr) * 16 + tq) * 64, (const att::bf16_t*)(ws + WS_KBS) + (size_t)(bh * 2 + rr) * SPB * 64, (const att::bf16_t*)(ws + WS_VBST) + (size_t)bh * 128 * SPB, SPB,
                                         args.in[I_CBK] + (size_t)(bh >> 2) * 1024 * 512 + ((bh & 3) * 2 + rr) * 64, args.in[I_CBV] + (size_t)(bh >> 2) * 1024 * 512 + (bh & 3) * 128, 32,
                                         wq, 4, 33, 1040, 0, tbl, oo, mm, ll, lane);
                if (wq > 0) { LAS float* pw = (LAS float*)(L + (rr * 3 + wq - 1) * 16384) + lane; asm volatile("" : "+v"(pw));
#pragma unroll
                    for (int d = 0; d < 4; ++d)
#pragma unroll
                        for (int t = 0; t < 16; ++t) pw[(d * 16 + t) * 64] = oo[d][t]; }
                pml[wave * 128 + lane] = mm; pml[wave * 128 + 64 + lane] = ll;
                __syncthreads();
                LAS float* stash = (LAS float*)(L + 6 * 16384) + lane; asm volatile("" : "+v"(stash));
                if (wq == 0) {
                    const LAS float* pg = pml + rr * 512 + lane;
                    float M = pg[0], Ls = 0.f;
#pragma unroll
                    for (int i = 1; i < 4; ++i) M = fmaxf(M, pg[i * 128]);
#pragma unroll
                    for (int i = 0; i < 4; ++i) Ls += pg[i * 128 + 64] * __builtin_amdgcn_exp2f(pg[i * 128] - M);
                    const float inv = 1.0f / Ls, e0 = __builtin_amdgcn_exp2f(mm - M) * inv;
#pragma unroll
                    for (int d = 0; d < 4; ++d)
#pragma unroll
                        for (int t = 0; t < 16; ++t) oo[d][t] *= e0;
#pragma unroll 1
                    for (int i = 1; i < 4; ++i) {
                        const float ei = __builtin_amdgcn_exp2f(pg[i * 128] - M) * inv;
                        const LAS float* pi = (const LAS float*)(L + (rr * 3 + i - 1) * 16384) + lane; asm volatile("" : "+v"(pi));
#pragma unroll
                        for (int d = 0; d < 4; ++d)
#pragma unroll
                            for (int t = 0; t < 16; ++t) oo[d][t] += pi[(d * 16 + t) * 64] * ei;
                    }
                    if (rr == 1) {
#pragma unroll
                        for (int d = 0; d < 4; ++d)
#pragma unroll
                            for (int t = 0; t < 16; ++t) stash[(d * 16 + t) * 64] = oo[d][t];
                    }
                }
                __syncthreads();
                if (wave == 0) {
                    att::f32x16 o2[4];
#pragma unroll
                    for (int d = 0; d < 4; ++d)
#pragma unroll
                        for (int t = 0; t < 16; ++t) o2[d][t] = stash[(d * 16 + t) * 64];
                    att::finish_b(oo, o2, 1.0f, lam, subg, yb + ((size_t)32768 + (bh >> 2) * 16 + tq) * 512 + (bh & 3) * 128, h, r < 16);
                }
            }
        }
        __syncthreads();
    }
    xcd_barrier(xbar);
    {
        pg8::StaticOrder S; S.init(32768, 1024, G, bx);
        { pg8::Gemm g{(const pg8::bf16_t*)(ws + WS_YA), (const pg8::bf16_t*)(ws + WS_WPA), 32768, 1024, 512, 512};
          pg8::EpiP3<0> E{(const unsigned char*)(ws + WS_GATE), (pg8::bf16_t*)(ws + WS_MBUF)};
          pg8::gemm_phase<pg8::EpiP3<0>, pg8::StaticOrder, true, true>(L, g, S, E); }
        { pg8::Gemm g{(const pg8::bf16_t*)(ws + WS_YB), (const pg8::bf16_t*)(ws + WS_WPB), 32768, 1024, 512, 512};
          pg8::EpiP3<1> E{(const unsigned char*)(ws + WS_GATE), (pg8::bf16_t*)(ws + WS_MBUF)};
          pg8::gemm_phase<pg8::EpiP3<1>, pg8::StaticOrder, true, true>(L, g, S, E); }
        { const int pass = (bx >> 3) & 1, pn = (bx >> 1) & 3, ks = bx & 1;
          pg8::Gemm g{(const pg8::bf16_t*)(ws + (pass ? WS_YB : WS_YA)) + (size_t)32768 * 512 + ks * 256, (const pg8::bf16_t*)(ws + (pass ? WS_WPB : WS_WPA)) + ks * 256, 256, 1024, 512, 256}; pg8::OneUnit S1{bx < 16, pn};
          pg8::EpiP3Part E{(const unsigned char*)(ws + WS_GATE), pass * 1024, (float*)(ws + WS_PART + 8 * MiB) + (size_t)(pass * 2 + ks) * 256 * 1024};
          pg8::gemm_phase<pg8::EpiP3Part, pg8::OneUnit, true, true>(L, g, S1, E); }
    }
    xcd_barrier(xbar);

    {
        { pg8::Gemm g{(const pg8::bf16_t*)(ws + WS_MBUF), (const pg8::bf16_t*)(ws + WS_WOUT), 32768, 1024, 1024, 1024}; pg8::StaticOrder S; S.init(32768, 1024, G, bx);
          pg8::EpiP4 E{(const pg8::bf16_t*)(ws + WS_H), (const float*)(ws + WS_RINV), args.in[I_LN1], (pg8::bf16_t*)(ws + WS_X1G), (float*)(ws + WS_SSQ)};
          pg8::gemm_phase<pg8::EpiP4, pg8::StaticOrder, true, true>(L, g, S, E); }
        { const int pn = bx >> 2, ks = bx & 3;
          if (bx < 16) {
              const int t_ = wave * 64 + lane_id();
              for (int i = 0; i < 32; ++i) { const int e = i * 512 + t_, row = e >> 6, col = ks * 256 + 4 * (e & 63);
                  const float* pp = (const float*)(ws + WS_PART + 8 * MiB) + (size_t)row * 1024 + col;
                  f32x4 a = *(const f32x4*)pp;
#pragma unroll
                  for (int k = 1; k < 4; ++k) a += *(const f32x4*)(pp + (size_t)k * 256 * 1024);
                  *(unsigned long long*)((bf16*)(ws + WS_MBUF) + ((size_t)32768 + row) * 1024 + col) = (unsigned long long)pg8::pkbf(a[0], a[1]) | ((unsigned long long)pg8::pkbf(a[2], a[3]) << 32); }
              asm volatile("s_waitcnt vmcnt(0)" ::: "memory");
              __syncthreads();
          }
          pg8::Gemm g{(const pg8::bf16_t*)(ws + WS_MBUF) + (size_t)32768 * 1024 + ks * 256, (const pg8::bf16_t*)(ws + WS_WOUT) + ks * 256, 256, 1024, 1024, 256}; pg8::OneUnit S{bx < 16, pn};
          pg8::EpiP6Part E{(float*)(ws + WS_PART) + (size_t)ks * 256 * 1024};
          pg8::gemm_phase<pg8::EpiP6Part, pg8::OneUnit, true, true>(L, g, S, E); }
        xcd_barrier(xbar);
        if (gw < 256) {
            const int ln = lane_id(); const size_t row = (size_t)32768 + gw;
            const float rms = ((const float*)(ws + WS_RINV))[row]; float ss = 0.f;
#pragma unroll
            for (int j = 0; j < 4; ++j) { const int c = 256 * j + 4 * ln;
                f32x4 a = ((const f32x4*)((const float*)(ws + WS_PART) + (size_t)gw * 1024 + c))[0];
#pragma unroll
                for (int k = 1; k < 4; ++k) a += ((const f32x4*)((const float*)(ws + WS_PART) + (size_t)k * 256 * 1024 + (size_t)gw * 1024 + c))[0];
                const unsigned long long hq = *(const unsigned long long*)((const bf16*)(ws + WS_H) + row * 1024 + c);
                const f32x4 g1v = *(const f32x4*)(args.in[I_LN1] + c);
                const f32x4 xv = (f32x4){pg8::bflo((unsigned)hq), pg8::bfhi((unsigned)hq), pg8::bflo((unsigned)(hq >> 32)), pg8::bfhi((unsigned)(hq >> 32))} * rms / g1v;
                const f32x4 v = xv + a;
                ss += (v[0] * v[0] + v[1] * v[1]) + (v[2] * v[2] + v[3] * v[3]);
                *(unsigned long long*)((bf16*)(ws + WS_X1G) + row * 1024 + c) = (unsigned long long)pg8::pkbf(v[0], v[1]) | ((unsigned long long)pg8::pkbf(v[2], v[3]) << 32); }
            ss = wave_sum(ss);
            if (ln == 0) ((float*)(ws + WS_SSQ))[row] = ss;
        }
    }
    xcd_barrier(xbar);

    {
        pg8::Gemm g{(const pg8::bf16_t*)(ws + WS_X1G), (const pg8::bf16_t*)(ws + WS_WFF1), MROWS, 4096, 1024, 1024}; pg8::StaticOrder S; S.init(MROWS, 4096, G, bx);
        pg8::EpiP5 E{(const float*)(ws + WS_SSQ), (pg8::bf16_t*)(ws + WS_U)};
        pg8::gemm_phase<pg8::EpiP5, pg8::StaticOrder, true, true>(L, g, S, E);
    }
    xcd_barrier(xbar);

    {
        { pg8::Gemm g{(const pg8::bf16_t*)(ws + WS_U), (const pg8::bf16_t*)(ws + WS_WFF2), 32768, 1024, 4096, 4096}; pg8::StaticOrder S; S.init(32768, 1024, G, bx);
          pg8::EpiP6 E{(const pg8::bf16_t*)(ws + WS_X1G), out + O_Y};
          pg8::gemm_phase<pg8::EpiP6, pg8::StaticOrder, true, true>(L, g, S, E); }
        { const int pn = bx >> 4, ks = bx & 15;
          pg8::Gemm g{(const pg8::bf16_t*)(ws + WS_U) + (size_t)32768 * 4096 + ks * 256, (const pg8::bf16_t*)(ws + WS_WFF2) + ks * 256, 256, 1024, 4096, 256}; pg8::OneUnit S{bx < 64, pn};
          pg8::EpiP6Part E{(float*)(ws + WS_PART) + (size_t)ks * 256 * 1024};
          pg8::gemm_phase<pg8::EpiP6Part, pg8::OneUnit, true, true>(L, g, S, E); }
        xcd_barrier(xbar);
        { const int gt = gw * 64 + lane_id();
          if (gt < 65536) { const f32x4* pp = (const f32x4*)(ws + WS_PART) + gt; const unsigned long long xq = ((const unsigned long long*)((const bf16*)(ws + WS_X1G) + (size_t)32768 * 1024))[gt];
              f32x4 a = {pg8::bflo((unsigned)xq), pg8::bfhi((unsigned)xq), pg8::bflo((unsigned)(xq >> 32)), pg8::bfhi((unsigned)(xq >> 32))}; f32x4 v[16];
#pragma unroll
              for (int k = 0; k < 16; ++k) v[k] = pp[(size_t)k * 65536];
#pragma unroll
              for (int k = 0; k < 16; ++k) a += v[k];
              ((f32x4*)(out + O_Y + (size_t)32768 * 1024))[gt] = a; } }
    }
}

extern "C" void kernel_launch(void* const* d_in, const int* in_sizes, int n_in, void* d_out, int out_size, void* d_ws, size_t ws_size, hipStream_t stream) {
    static int grid = 0;
    if (grid == 0) {
        if (n_in != 26 || ws_size < WS_END) { fprintf(stderr, "kernel_launch: unexpected n_in %d / ws %zu\n", n_in, ws_size); grid = -1; return; }
        int dev = 0, cus = 0, per_cu = 0;
        hipGetDevice(&dev); hipDeviceGetAttribute(&cus, hipDeviceAttributeMultiprocessorCount, dev);
        if (hipFuncSetAttribute((const void*)mega_fwd, hipFuncAttributeMaxDynamicSharedMemorySize, LDS_BYTES) != hipSuccess) { fprintf(stderr, "kernel_launch: hipFuncSetAttribute failed\n"); grid = -1; return; }
        if (hipOccupancyMaxActiveBlocksPerMultiprocessor(&per_cu, (const void*)mega_fwd, NWAVES * 64, LDS_BYTES) != hipSuccess || per_cu < 1) { fprintf(stderr, "kernel_launch: occupancy query says %d\n", per_cu); per_cu = 1; }
        (void)hipGetLastError();
        grid = cus;
    }
    if (grid < 0) return;
    Args a{};
    for (int i = 0; i < 26; ++i) a.in[i] = (const float*)d_in[i];
    a.out = (float*)d_out; a.ws = (unsigned char*)d_ws;
    void* kargs[] = {&a};
    hipError_t e = hipLaunchCooperativeKernel((const void*)mega_fwd, dim3(grid), dim3(NWAVES * 64), kargs, LDS_BYTES, stream);
    if (e != hipSuccess) fprintf(stderr, "cooperative launch failed: %s (grid %d)\n", hipGetErrorString(e), grid);
}
```
